# Optimizing an MI355X kernel written in HIP

```python
import math
import jax
import jax.numpy as jnp
from jax import lax
import numpy as np

D_MODEL = 1024
BATCH = 16
SEQ = 4096
DEPTH = 1

GRID_W = 64
CTX_LEN = 256
NORM_EPS = 1e-6

POOL_WINDOWS = (2, 4, 8, 16)
N_POOL_GROUPS = 4
POOL_WIDTH = D_MODEL
POOL_GROUP = POOL_WIDTH // N_POOL_GROUPS

SSD_EXPAND = 2
D_INNER = SSD_EXPAND * D_MODEL
HEAD_DIM = 64
N_HEADS = D_INNER // HEAD_DIM
D_STATE = 128
N_BC_GROUPS = 4
CONV_K = 4
CONV_LEFT = CONV_K // 2
CHUNK = 128
N_DIR = 2
SSD_NORM_GROUPS = N_BC_GROUPS
CONV_DIM = D_INNER + 2 * N_BC_GROUPS * D_STATE

N_BRANCH = 2
OFF_POOL_V = 0
OFF_POOL_Z = OFF_POOL_V + POOL_WIDTH
OFF_SSD_Z = OFF_POOL_Z + POOL_WIDTH
OFF_GATE = OFF_SSD_Z + D_INNER
OFF_XBC = OFF_GATE + N_BRANCH * D_MODEL
OFF_DT = OFF_XBC + CONV_DIM
IN_COLS = OFF_DT + N_DIR * N_HEADS

kernel_name = 'hybrid_pool_ssd_diffusion_block'


def rmsnorm(x, w):
    xf = x.astype(jnp.float32)
    y = xf * lax.rsqrt(jnp.mean(xf * xf, axis=-1, keepdims=True) + NORM_EPS)
    return (y * w.astype(jnp.float32)).astype(x.dtype)


def adaln(cond, w_ada, b_ada):
    mod = jax.nn.silu(cond) @ w_ada + b_ada
    return jnp.split(mod, 3, axis=-1)


def centred_dwconv(u, w, b):
    l = u.shape[1]
    up = jnp.pad(u, ((0, 0), (CONV_LEFT, CONV_K - 1 - CONV_LEFT), (0, 0)))
    out = up[:, 0:l] * w[0]
    for k in range(1, CONV_K):
        out = out + up[:, k:k + l] * w[k]
    return out + b


def box_mean(v, k, axis):
    n = v.shape[axis]
    lo, hi = k // 2, k - 1 - k // 2
    cs = jnp.cumsum(v.astype(jnp.float32), axis=axis)
    pad = [(0, 0)] * v.ndim
    pad[axis] = (1, 0)
    cs = jnp.pad(cs, pad)
    t = jnp.arange(n)
    i_hi = jnp.minimum(t + hi + 1, n)
    i_lo = jnp.maximum(t - lo, 0)
    s = jnp.take(cs, i_hi, axis=axis) - jnp.take(cs, i_lo, axis=axis)
    shape = [1] * v.ndim
    shape[axis] = n
    cnt = (i_hi - i_lo).astype(jnp.float32).reshape(shape)
    return (s / cnt).astype(v.dtype)


def pool_mixer(v, pool_w, pool_scale, rows):
    b, l, _ = v.shape
    diffs = []
    for gi, k in enumerate(POOL_WINDOWS):
        vg = v[..., gi * POOL_GROUP:(gi + 1) * POOL_GROUP]
        if rows is None:
            m = box_mean(vg, k, 1)
        else:
            vg2 = vg.reshape(b, rows, GRID_W, POOL_GROUP)
            m = box_mean(box_mean(vg2, k, 1), k, 2).reshape(b, l, POOL_GROUP)
        diffs.append(m - vg)
    d = jnp.stack(diffs, axis=2)
    y = jnp.einsum('blgi,gio->blgo', d, pool_w).reshape(b, l, POOL_WIDTH)
    return y * pool_scale


def ssd_prep(xbc_raw, dt_raw, conv_w, conv_b, dt_bias, a_log):
    b, l, _ = xbc_raw.shape
    xbc = jax.nn.silu(centred_dwconv(xbc_raw, conv_w, conv_b))
    bc = N_BC_GROUPS * D_STATE
    xs = xbc[..., :D_INNER].reshape(b, l, N_HEADS, HEAD_DIM)
    Bm = xbc[..., D_INNER:D_INNER + bc].reshape(b, l, N_BC_GROUPS, D_STATE)
    Cm = xbc[..., D_INNER + bc:].reshape(b, l, N_BC_GROUPS, D_STATE)
    dt = jax.nn.softplus((dt_raw.reshape(b, l, N_DIR, N_HEADS) + dt_bias).astype(jnp.float32))
    A = -jnp.exp(a_log.astype(jnp.float32))
    return xs, Bm, Cm, dt, A


def ssd_scan(xs, dt, A, Bm, Cm, h0, with_output):
    b, l, h, p = xs.shape
    g, n = Bm.shape[2], Bm.shape[3]
    r = h // g
    nc = l // CHUNK
    a_cs = jnp.cumsum((dt * A).reshape(b, nc, CHUNK, g, r), axis=2)
    xdt = (xs * dt[..., None].astype(xs.dtype)).reshape(b, nc, CHUNK, g, r, p)
    Br = Bm.reshape(b, nc, CHUNK, g, n)
    a_last = a_cs[:, :, -1]
    to_end = jnp.exp(a_last[:, :, None] - a_cs).astype(xs.dtype)
    states = jnp.einsum('bcjgn,bcjgrp->bcgrpn', Br, xdt * to_end[..., None])
    chunk_decay = jnp.exp(a_last).astype(xs.dtype)
    if h0 is None:
        h0 = jnp.zeros((b, h, p, n), xs.dtype)

    def step(carry, inp):
        s, d = inp
        nxt = d[..., None, None] * carry + s
        return nxt, (carry if with_output else None)

    h_final, h_start = lax.scan(step, h0.reshape(b, g, r, p, n),
                                (jnp.moveaxis(states, 1, 0), jnp.moveaxis(chunk_decay, 1, 0)))
    h_final = h_final.reshape(b, h, p, n)
    if not with_output:
        return None, h_final
    h_start = jnp.moveaxis(h_start, 0, 1)
    Cr = Cm.reshape(b, nc, CHUNK, g, n)
    seg = a_cs[:, :, :, None] - a_cs[:, :, None]
    lower = jnp.tril(jnp.ones((CHUNK, CHUNK), dtype=bool))[:, :, None, None]
    L = jnp.exp(jnp.where(lower, seg, -jnp.inf)).astype(xs.dtype)
    cb = jnp.einsum('bcign,bcjgn->bcijg', Cr, Br)
    y_diag = jnp.einsum('bcijgr,bcjgrp->bcigrp', cb[..., None] * L, xdt)
    y_off = jnp.einsum('bcign,bcgrpn->bcigrp', Cr, h_start) * jnp.exp(a_cs).astype(xs.dtype)[..., None]
    return (y_diag + y_off).reshape(b, l, h, p), h_final


def bidir_ssd(xs, dt, A, Bm, Cm, h0_f, h0_b, with_output):
    fl = lambda t: jnp.flip(t, axis=1)
    y_f, st_f = ssd_scan(xs, dt[:, :, 0], A[0], Bm, Cm, h0_f, with_output)
    y_b, st_b = ssd_scan(fl(xs), fl(dt[:, :, 1]), A[1], fl(Bm), fl(Cm), h0_b, with_output)
    y = (y_f + fl(y_b)) if with_output else None
    return y, st_f, st_b


def gated_group_rmsnorm(y, z, w):
    b, l, d = y.shape
    u = (y * jax.nn.silu(z)).astype(jnp.float32).reshape(b, l, SSD_NORM_GROUPS, d // SSD_NORM_GROUPS)
    u = u * lax.rsqrt(jnp.mean(u * u, axis=-1, keepdims=True) + NORM_EPS)
    return (u.reshape(b, l, d) * w.astype(jnp.float32)).astype(y.dtype)


def mixer(h, w_in, b_merge, pool_w, pool_scale, conv_w, conv_b, dt_bias, a_log, d_skip, ssd_norm,
          w_proj_pool, w_proj_ssd, w_out, h0_f, h0_b, rows):
    b, l, _ = h.shape
    proj = h @ w_in
    v = proj[..., OFF_POOL_V:OFF_POOL_Z]
    z_pool = proj[..., OFF_POOL_Z:OFF_SSD_Z]
    z_ssd = proj[..., OFF_SSD_Z:OFF_GATE]
    gates = jax.nn.sigmoid(proj[..., OFF_GATE:OFF_XBC] + b_merge)
    xbc_raw = proj[..., OFF_XBC:OFF_DT]
    dt_raw = proj[..., OFF_DT:]
    y_pool = pool_mixer(v, pool_w, pool_scale, rows) * jax.nn.silu(z_pool)
    xs, Bm, Cm, dt, A = ssd_prep(xbc_raw, dt_raw, conv_w, conv_b, dt_bias, a_log)
    y_ssd, st_f, st_b = bidir_ssd(xs, dt, A, Bm, Cm, h0_f, h0_b, True)
    y_ssd = (y_ssd + d_skip[:, None] * xs).reshape(b, l, D_INNER)
    y_ssd = gated_group_rmsnorm(y_ssd, z_ssd, ssd_norm)
    merged = gates[..., :D_MODEL] * (y_pool @ w_proj_pool) + gates[..., D_MODEL:] * (y_ssd @ w_proj_ssd)
    return merged @ w_out, st_f, st_b


def context_states(hc, w_in, conv_w, conv_b, dt_bias, a_log):
    proj = hc @ w_in[:, OFF_XBC:]
    xs, Bm, Cm, dt, A = ssd_prep(proj[..., :CONV_DIM], proj[..., CONV_DIM:], conv_w, conv_b, dt_bias, a_log)
    _, st_f, st_b = bidir_ssd(xs, dt, A, Bm, Cm, None, None, False)
    return st_f, st_b


def _normal(key, shape, scale):
    return jax.random.normal(key, shape, jnp.float32) * scale


def setup_inputs(seed: int = 0) -> dict:
    key = jax.random.key(seed)
    ks = jax.random.split(key, 24)
    D = D_MODEL
    dt0 = jnp.exp(jax.random.uniform(ks[12], (DEPTH, N_DIR, N_HEADS), jnp.float32,
                                     minval=math.log(1e-3), maxval=math.log(1e-1)))
    return {
        'x': _normal(ks[0], (BATCH, SEQ, D), 1.0),
        'c': _normal(ks[1], (BATCH, D), 1.0),
        'ctx': _normal(ks[2], (BATCH, CTX_LEN, D), 1.0),
        'c_ctx': _normal(ks[3], (D,), 1.0),
        'w_ada': _normal(ks[4], (DEPTH, D, 3 * D), 0.5 * D ** -0.5),
        'b_ada': _normal(ks[5], (DEPTH, 3 * D), 0.02),
        'norm_pre': 1.0 + _normal(ks[6], (DEPTH, D), 0.05),
        'norm_post': 1.0 + _normal(ks[7], (DEPTH, D), 0.05),
        'w_in': _normal(ks[8], (DEPTH, D, IN_COLS), D ** -0.5),
        'b_merge': _normal(ks[9], (DEPTH, N_BRANCH * D), 0.02),
        'pool_w': _normal(ks[10], (DEPTH, N_POOL_GROUPS, POOL_GROUP, POOL_GROUP), POOL_GROUP ** -0.5),
        'pool_scale': 1.0 + _normal(ks[11], (DEPTH, POOL_WIDTH), 0.05),
        'conv_w': _normal(ks[13], (DEPTH, CONV_K, CONV_DIM), CONV_K ** -0.5),
        'conv_b': _normal(ks[14], (DEPTH, CONV_DIM), 0.02),
        'dt_bias': dt0 + jnp.log(-jnp.expm1(-dt0)),
        'a_log': jnp.log(jax.random.uniform(ks[15], (DEPTH, N_DIR, N_HEADS), jnp.float32, minval=1.0, maxval=16.0)),
        'd_skip': 1.0 + _normal(ks[16], (DEPTH, N_HEADS), 0.05),
        'ssd_norm': 1.0 + _normal(ks[17], (DEPTH, D_INNER), 0.05),
        'w_proj_pool': _normal(ks[18], (DEPTH, POOL_WIDTH, D), POOL_WIDTH ** -0.5),
        'w_proj_ssd': _normal(ks[19], (DEPTH, D_INNER, D), D_INNER ** -0.5),
        'w_out': _normal(ks[20], (DEPTH, D, D), D ** -0.5),
    }


def reference(x, c, ctx, c_ctx, w_ada, b_ada, norm_pre, norm_post, w_in, b_merge, pool_w, pool_scale,
              conv_w, conv_b, dt_bias, a_log, d_skip, ssd_norm, w_proj_pool, w_proj_ssd, w_out):
    rows = x.shape[1] // GRID_W
    for layer in range(DEPTH):
        shift, scale, gate = adaln(c[:, None, :], w_ada[layer], b_ada[layer])
        shift_c, scale_c, gate_c = adaln(c_ctx, w_ada[layer], b_ada[layer])
        hc = rmsnorm(ctx, norm_pre[layer]) * (1.0 + scale_c) + shift_c
        if layer + 1 < DEPTH:
            out_c, st_f, st_b = mixer(hc, w_in[layer], b_merge[layer], pool_w[layer], pool_scale[layer],
                                      conv_w[layer], conv_b[layer], dt_bias[layer], a_log[layer],
                                      d_skip[layer], ssd_norm[layer], w_proj_pool[layer],
                                      w_proj_ssd[layer], w_out[layer], None, None, None)
            ctx_next = ctx + gate_c * rmsnorm(out_c, norm_post[layer])
        else:
            st_f, st_b = context_states(hc, w_in[layer], conv_w[layer], conv_b[layer],
                                        dt_bias[layer], a_log[layer])
            ctx_next = ctx
        hx = rmsnorm(x, norm_pre[layer]) * (1.0 + scale) + shift
        out_x, _, _ = mixer(hx, w_in[layer], b_merge[layer], pool_w[layer], pool_scale[layer],
                            conv_w[layer], conv_b[layer], dt_bias[layer], a_log[layer],
                            d_skip[layer], ssd_norm[layer], w_proj_pool[layer],
                            w_proj_ssd[layer], w_out[layer], st_f, st_b, rows)
        x = x + gate * rmsnorm(out_x, norm_post[layer])
        ctx = ctx_next
    return x
```

```cpp
#include <hip/hip_runtime.h>
#include <hip/hip_cooperative_groups.h>
#include <cstdio>
#include <cstdint>
namespace cg = cooperative_groups;
namespace pg8 {
#define PG8_LAS __attribute__((address_space(3)))
typedef unsigned short bf16_t;
typedef short bf16x8 __attribute__((ext_vector_type(8)));
typedef float f32x4 __attribute__((ext_vector_type(4)));
typedef unsigned u32x4 __attribute__((ext_vector_type(4)));
constexpr int BM = 256, BK = 64, HALF = 128, HTB = HALF * BK * 2  , STAGE_BYTES = 8 * HTB, NXCD = 8, WGM = 8;

__host__ __device__ __forceinline__ int lds_byte(int r, int c) { const int st = (r >> 4) * 2 + (c >> 5), rr = r & 15, cc = c & 31, ob = rr * 64 + cc * 2; return st * 1024 + (ob ^ (((ob >> 9) & 1) << 5)); }
__host__ __device__ __forceinline__ void stage_rc(int b, int& R, int& C) { const int st = b / 1024, sb = b % 1024, swz = sb ^ (((sb >> 9) & 1) << 5); R = (st >> 1) * 16 + swz / 64; C = (st & 1) * 32 + (swz % 64) / 2; }
__host__ __device__ __forceinline__ int perm32(int rho) { const int n = rho >> 4, i = rho & 15; return 8 * (i >> 2) + 4 * n + (i & 3); }

struct Unit { int pm, pn; };
struct Gemm { const bf16_t* A; const bf16_t* Bt; int lda, ldb, K, a_pn_off; };
struct StaticOrder {
    int nM, nN, nwg, G, c;
    __host__ __device__ void init(int M, int N, int G_, int c_) { nM = M / BM; nN = N / BM; nwg = nM * nN; G = G_; c = c_; }
    __host__ __device__ bool next(int i, Unit& u) const {
        const long L = (long)i * G + c; if (L >= nwg) return false;
        int wgid = (int)L; { const int q = nwg / NXCD, r = nwg % NXCD, xcd = wgid % NXCD, off = wgid / NXCD; wgid = (xcd < r ? xcd * (q + 1) : r * (q + 1) + (xcd - r) * q) + off; }
        const int nig = WGM * nN, gid = wgid / nig, fm = gid * WGM, gsz = (nM - fm) < WGM ? (nM - fm) : WGM;
        u.pm = fm + ((wgid % nig) % gsz); u.pn = (wgid % nig) / gsz; return true;
    }
    __device__ __forceinline__ void a_ready(const Unit&) const {}
    __device__ __forceinline__ void done(const Unit&) const {}
};
__device__ __forceinline__ unsigned cvt_pk_bf16(float lo, float hi) { unsigned r; asm volatile("v_cvt_pk_bf16_f32 %0, %1, %2" : "=v"(r) : "v"(lo), "v"(hi)); return r; }
template <class Epi, class Sched, bool ALIGN_EPI = false, bool SP2 = false>
__device__ __forceinline__ void gemm_phase(PG8_LAS unsigned char* lds, const Gemm g, const Sched& S, const Epi& E, int tid_in) {
    int tid_l = tid_in; asm volatile("" : "+v"(tid_l));
    const int tid = tid_l, wid = __builtin_amdgcn_readfirstlane(tid >> 6), lane = tid & 63, wr = wid >> 2, wc = wid & 3, fr = lane & 15, fq = lane >> 4;
    const int K = g.K, nt = K / BK;
    unsigned voffA[2], voffB[2];
#pragma unroll
    for (int i = 0; i < 2; ++i) { int R, C; stage_rc(tid * 16 + i * 8192, R, C); const int Rb = Epi::PERM ? ((R & ~31) + perm32(R & 31)) : R;
        voffA[i] = (unsigned)(R * g.lda + C) * 2u; voffB[i] = (unsigned)(Rb * g.ldb + C) * 2u; }
    const size_t kstep = (size_t)(BK * 2);
    const size_t hstepA = (size_t)HALF * g.lda * 2, hstepB = (size_t)HALF * g.ldb * 2;
    const size_t tstepA = 2 * hstepA, tstepB = 2 * hstepB, pnoffA = (size_t)g.a_pn_off * 2;
    const unsigned ldsw = (unsigned)wid * 1024u;
    const int aoff = lds_byte(wr * 64 + fr, fq * 8), boff = lds_byte(wc * 32 + fr, fq * 8);
#define PG8_SA(b, h) (((b) * 2 + (h)) * HTB)
#define PG8_SB(b, h) ((4 + (b) * 2 + (h)) * HTB)
#define PG8_STAGE(bufoff, gbase, voff) do { _Pragma("unroll") for (int _i = 0; _i < 2; ++_i) \
        __builtin_amdgcn_global_load_lds((const unsigned*)((const char*)(gbase) + (voff)[_i]), (PG8_LAS unsigned*)(lds + (bufoff) + ldsw + _i * 8192), 16, 0, 0); } while (0)
#define PG8_LDA(dst, b, h) do { _Pragma("unroll") for (int m = 0; m < 4; ++m) _Pragma("unroll") for (int k = 0; k < 2; ++k) dst[m][k] = *(const PG8_LAS bf16x8*)(lds + PG8_SA(b, h) + aoff + m * 2048 + k * 1024); } while (0)
#define PG8_LDB(dst, b, h) do { _Pragma("unroll") for (int n = 0; n < 2; ++n) _Pragma("unroll") for (int k = 0; k < 2; ++k) dst[n][k] = *(const PG8_LAS bf16x8*)(lds + PG8_SB(b, h) + boff + n * 2048 + k * 1024); } while (0)
#define PG8_MMA(ai, bj, At, Bt) do { __builtin_amdgcn_s_setprio(1); _Pragma("unroll") for (int m = 0; m < 4; ++m) _Pragma("unroll") for (int n = 0; n < 2; ++n) _Pragma("unroll") for (int k = 0; k < 2; ++k) \
        acc[ai][bj][m][n] = __builtin_amdgcn_mfma_f32_16x16x32_bf16(Bt[n][k], At[m][k], acc[ai][bj][m][n], 0, 0, 0); __builtin_amdgcn_s_setprio(0); } while (0)
#define PG8_WAIT_V(n) asm volatile("s_waitcnt vmcnt(" #n ")" ::: "memory")
#define PG8_WAIT_L(n) asm volatile("s_waitcnt lgkmcnt(" #n ")" ::: "memory")
#define PG8_BAR __builtin_amdgcn_s_barrier()
#define PG8_SCHED __builtin_amdgcn_sched_barrier(0)
    Unit cur, nxt; int ui = 0;
    if (!S.next(0, cur)) return;
    f32x4 acc[2][2][4][2];
#pragma unroll
    for (int a = 0; a < 2; ++a)
#pragma unroll
        for (int b = 0; b < 2; ++b)
#pragma unroll
            for (int m = 0; m < 4; ++m)
#pragma unroll
                for (int n = 0; n < 2; ++n) acc[a][b][m][n] = (f32x4){0.f, 0.f, 0.f, 0.f};
    bf16x8 At[4][2], B0[2][2], B1[2][2];
    const char* cA = (const char*)g.A + (size_t)cur.pm * tstepA + (size_t)cur.pn * pnoffA; const char* cB = (const char*)g.Bt + (size_t)cur.pn * tstepB;
    S.a_ready(cur);
    if constexpr (SP2) {
        PG8_STAGE(PG8_SB(0, 0), cB, voffB); PG8_STAGE(PG8_SB(0, 1), cB + hstepB, voffB); PG8_STAGE(PG8_SA(0, 0), cA, voffA); PG8_STAGE(PG8_SA(0, 1), cA + hstepA, voffA);
        if (wr == 1) PG8_BAR;
        PG8_WAIT_V(2); PG8_BAR;
        PG8_STAGE(PG8_SB(1, 0), cB + kstep, voffB); PG8_STAGE(PG8_SA(1, 0), cA + kstep, voffA); PG8_STAGE(PG8_SB(1, 1), cB + hstepB + kstep, voffB);
        PG8_WAIT_V(6); PG8_BAR;
    } else {
        PG8_STAGE(PG8_SB(0, 0), cB, voffB); PG8_STAGE(PG8_SA(0, 0), cA, voffA); PG8_STAGE(PG8_SB(0, 1), cB + hstepB, voffB); PG8_STAGE(PG8_SA(0, 1), cA + hstepA, voffA);
        if (wr == 1) PG8_BAR;
        PG8_WAIT_V(4); PG8_BAR;
        PG8_STAGE(PG8_SB(1, 0), cB + kstep, voffB); PG8_STAGE(PG8_SA(1, 0), cA + kstep, voffA); PG8_STAGE(PG8_SB(1, 1), cB + hstepB + kstep, voffB);
        PG8_WAIT_V(6); PG8_BAR;
    }
    for (;;) {
        const bool has_next = S.next(ui + 1, nxt);
        const char* nA = has_next ? (const char*)g.A + (size_t)nxt.pm * tstepA + (size_t)nxt.pn * pnoffA : cA; const char* nB = has_next ? (const char*)g.Bt + (size_t)nxt.pn * tstepB : cB;
        for (int t = 0; t < nt; t += 2) {
            const bool last = (t == nt - 2);
            const char* a1 = cA + (size_t)(t + 1) * kstep;
            const char* a2 = last ? nA : cA + (size_t)(t + 2) * kstep; const char* b2 = last ? nB : cB + (size_t)(t + 2) * kstep;
            const char* a3 = a2 + kstep; const char* b3 = b2 + kstep;
            if (last && has_next) S.a_ready(nxt);
            if constexpr (SP2) {
            PG8_LDB(B0, 0, 0); PG8_LDB(B1, 0, 1); PG8_SCHED; PG8_LDA(At, 0, 0); PG8_STAGE(PG8_SA(1, 1), a1 + hstepA, voffA);
            PG8_WAIT_V(8); PG8_WAIT_L(0); PG8_BAR; PG8_MMA(0, 0, At, B0); PG8_MMA(0, 1, At, B1); PG8_BAR; PG8_SCHED;
            PG8_LDA(At, 0, 1); PG8_STAGE(PG8_SB(0, 0), b2, voffB); PG8_STAGE(PG8_SB(0, 1), b2 + hstepB, voffB); PG8_STAGE(PG8_SA(0, 0), a2, voffA);
            PG8_WAIT_V(8); PG8_WAIT_L(0); PG8_BAR; PG8_MMA(1, 0, At, B0); PG8_MMA(1, 1, At, B1); PG8_BAR; PG8_SCHED;
            PG8_LDB(B0, 1, 0); PG8_LDB(B1, 1, 1); PG8_SCHED; PG8_LDA(At, 1, 0); PG8_STAGE(PG8_SA(0, 1), a2 + hstepA, voffA);
            PG8_WAIT_V(8); PG8_WAIT_L(0); PG8_BAR; PG8_MMA(0, 0, At, B0); PG8_MMA(0, 1, At, B1); PG8_BAR; PG8_SCHED;
            PG8_LDA(At, 1, 1); PG8_STAGE(PG8_SB(1, 0), b3, voffB); PG8_STAGE(PG8_SB(1, 1), b3 + hstepB, voffB); PG8_STAGE(PG8_SA(1, 0), a3, voffA);
            PG8_WAIT_V(8); PG8_WAIT_L(0); PG8_BAR; PG8_MMA(1, 0, At, B0); PG8_MMA(1, 1, At, B1); PG8_BAR; PG8_SCHED;
            } else {
            PG8_LDB(B0, 0, 0); PG8_SCHED; PG8_LDA(At, 0, 0); PG8_STAGE(PG8_SA(1, 1), a1 + hstepA, voffA);
            PG8_WAIT_L(8); PG8_BAR; PG8_WAIT_L(0); PG8_MMA(0, 0, At, B0); PG8_BAR; PG8_SCHED;
            PG8_LDB(B1, 0, 1); PG8_STAGE(PG8_SB(0, 0), b2, voffB);
            PG8_BAR; PG8_WAIT_L(0); PG8_MMA(0, 1, At, B1); PG8_BAR;
            PG8_LDA(At, 0, 1); PG8_STAGE(PG8_SA(0, 0), a2, voffA);
            PG8_BAR; PG8_WAIT_L(0); PG8_MMA(1, 0, At, B0); PG8_BAR; PG8_SCHED;
            PG8_STAGE(PG8_SB(0, 1), b2 + hstepB, voffB);
            PG8_WAIT_V(6); PG8_BAR; PG8_MMA(1, 1, At, B1); PG8_BAR;
            PG8_LDB(B0, 1, 0); PG8_SCHED; PG8_LDA(At, 1, 0); PG8_STAGE(PG8_SA(0, 1), a2 + hstepA, voffA);
            PG8_WAIT_L(8); PG8_BAR; PG8_WAIT_L(0); PG8_MMA(0, 0, At, B0); PG8_BAR; PG8_SCHED;
            PG8_LDB(B1, 1, 1); PG8_STAGE(PG8_SB(1, 0), b3, voffB);
            PG8_BAR; PG8_WAIT_L(0); PG8_MMA(0, 1, At, B1); PG8_BAR;
            PG8_LDA(At, 1, 1); PG8_STAGE(PG8_SA(1, 0), a3, voffA);
            PG8_BAR; PG8_WAIT_L(0); PG8_MMA(1, 0, At, B0); PG8_BAR; PG8_SCHED;
            PG8_STAGE(PG8_SB(1, 1), b3 + hstepB, voffB);
            PG8_WAIT_V(6); PG8_BAR; PG8_MMA(1, 1, At, B1); PG8_BAR;
            }
        }
        if constexpr (ALIGN_EPI) { if (wr == 0) PG8_BAR; }
        if constexpr (!Epi::AFTER_DRAIN) { E(acc, cur, wr, wc, fr, fq); S.done(cur); }
        if (!has_next) break;
#pragma unroll
        for (int a = 0; a < 2; ++a)
#pragma unroll
            for (int b = 0; b < 2; ++b)
#pragma unroll
                for (int m = 0; m < 4; ++m)
#pragma unroll
                    for (int n = 0; n < 2; ++n) acc[a][b][m][n] = (f32x4){0.f, 0.f, 0.f, 0.f};
        cur = nxt; cA = nA; cB = nB; ++ui;
        if constexpr (ALIGN_EPI) { if (wr == 1) PG8_BAR; }
    }
    PG8_WAIT_V(0);
    if constexpr (!ALIGN_EPI) { if (wr == 0) PG8_BAR; }
    PG8_BAR;
    if constexpr (Epi::AFTER_DRAIN) { E.fused(acc, cur, wr, wc, fr, fq, lds, wid, lane); S.done(cur); }
#undef PG8_SA
#undef PG8_SB
#undef PG8_STAGE
#undef PG8_LDA
#undef PG8_LDB
#undef PG8_MMA
#undef PG8_WAIT_V
#undef PG8_WAIT_L
#undef PG8_BAR
#undef PG8_SCHED
}
}
using pg8::bf16_t; using pg8::bf16x8; using pg8::f32x4; using pg8::u32x4; using pg8::cvt_pk_bf16;
#define LAS __attribute__((address_space(3)))
typedef unsigned u32x2 __attribute__((ext_vector_type(2)));
#define DI __device__ __forceinline__

constexpr int D = 1024, BATCH = 16, SEQ = 4096, CTXL = 256, NH = 32;
constexpr int INP = 9472;
constexpr int NB = 8, T = NB * SEQ, NGRP = BATCH / NB, CT = BATCH * CTXL;
constexpr float EPS = 1e-6f;
constexpr int NTHR = 512;
constexpr int LDS_BYTES = 147456;

constexpr size_t MiB = 1u << 20;
constexpr size_t al256(size_t x) { return (x + 255) & ~(size_t)255; }
constexpr size_t WS_WIN = 0;
constexpr size_t WS_WPP = WS_WIN + al256((size_t)INP * 1024 * 2);
constexpr size_t WS_WPS = WS_WPP + 2 * MiB;
constexpr size_t WS_WO = WS_WPS + 4 * MiB;
constexpr size_t WS_PW = WS_WO + 2 * MiB;
constexpr size_t WS_MOD = WS_PW + MiB / 2;
constexpr size_t WS_HC = WS_MOD + al256(17 * 3072 * 4);
constexpr size_t WS_CXBC = WS_HC + (size_t)CT * 1024 * 2;
constexpr size_t WS_CDT = WS_CXBC + (size_t)CT * 3072 * 2;
constexpr size_t WS_CXT = WS_CDT + (size_t)CT * 64 * 4;
constexpr size_t WS_CBT = WS_CXT + (size_t)CT * 2048 * 2;
constexpr size_t WS_CDTV = WS_CBT + (size_t)CT * 512 * 2;
constexpr size_t WS_CACS = WS_CDTV + (size_t)2 * CT * 32 * 4;
constexpr size_t WS_HX = WS_CACS + (size_t)2 * CT * 32 * 4;
constexpr size_t WS_V = WS_HX + (size_t)T * 1024 * 2;
constexpr size_t WS_SZS = WS_V + (size_t)T * 1024 * 2;
constexpr size_t WS_GATES = WS_SZS + (size_t)T * 2048 * 2;
constexpr size_t WS_XBC = WS_GATES + (size_t)T * 2048 * 2;
constexpr size_t WS_DTR = WS_XBC + (size_t)T * 3072 * 2;
constexpr size_t WS_XT = WS_DTR + (size_t)T * 64 * 4;
constexpr size_t WS_CG = WS_XT + (size_t)T * 2048 * 2;
constexpr size_t WS_BT = WS_CG + (size_t)T * 512 * 2;
constexpr size_t WS_GT = WS_BT + (size_t)T * 512 * 2;
constexpr size_t WS_DTV = WS_GT + (size_t)T * 512 * 2;
constexpr size_t WS_ACS = WS_DTV + (size_t)2 * T * 32 * 4;
constexpr size_t WS_END = WS_ACS + (size_t)2 * T * 32 * 4;
constexpr size_t WS_YF = WS_XBC, WS_YP = WS_XBC + (size_t)T * 2048 * 2, WS_YB = WS_HX, WS_MRG = WS_HX;
static_assert(WS_END <= 1024 * MiB, "workspace map");

DI float bflo(unsigned w) { return __uint_as_float(w << 16); }
DI float bfhi(unsigned w) { return __uint_as_float(w & 0xffff0000u); }
DI float silu_f(float x) { return x / (1.f + __expf(-x)); }
DI float sigm_f(float x) { return 1.f / (1.f + __expf(-x)); }
DI float wave_sum(float v, int lane) {
#pragma unroll
    for (int o = 1; o < 64; o <<= 1) v += __int_as_float(__builtin_amdgcn_ds_bpermute((lane ^ o) << 2, __float_as_int(v)));
    return v;
}
DI u32x4 pack8(const float* o) { u32x4 w; w.x = cvt_pk_bf16(o[0], o[1]); w.y = cvt_pk_bf16(o[2], o[3]); w.z = cvt_pk_bf16(o[4], o[5]); w.w = cvt_pk_bf16(o[6], o[7]); return w; }
DI void unpack8(u32x4 w, float* o) { o[0] = bflo(w.x); o[1] = bfhi(w.x); o[2] = bflo(w.y); o[3] = bfhi(w.y); o[4] = bflo(w.z); o[5] = bfhi(w.z); o[6] = bflo(w.w); o[7] = bfhi(w.w); }
#define MFMA16(a, b, c) __builtin_amdgcn_mfma_f32_16x16x32_bf16((a), (b), (c), 0, 0, 0)

DI int fresh_lane() { unsigned m = ~0u; asm volatile("" : "+s"(m)); int l = (int)__builtin_amdgcn_mbcnt_hi(m, __builtin_amdgcn_mbcnt_lo(m, 0u)); asm volatile("" : "+v"(l)); return l; }
struct EpiInProj {
    static constexpr bool PERM = true, AFTER_DRAIN = false;
    bf16_t *V, *SZP, *SZS, *GATES, *XBC; float* DT; const float* b_merge; int pn_base;
    __device__ __forceinline__ void operator()(const f32x4 (&acc)[2][2][4][2], const pg8::Unit& u, int wr, int wc, int, int) const { const int ln_ = fresh_lane(), fr = ln_ & 15, fq = ln_ >> 4;
        const int pn = u.pn + pn_base; int mode, ldc, colt; bf16_t* O;
        if (pn < 4) { mode = 0; O = V; ldc = 1024; colt = pn * 256; }
        else if (pn < 8) { mode = 1; O = SZP; ldc = 1024; colt = (pn - 4) * 256; }
        else if (pn < 16) { mode = 1; O = SZS; ldc = 2048; colt = (pn - 8) * 256; }
        else if (pn < 24) { mode = 2; O = GATES; ldc = 2048; colt = (pn - 16) * 256; }
        else if (pn < 36) { mode = 0; O = XBC; ldc = 3072; colt = (pn - 24) * 256; }
        else { mode = 3; O = nullptr; ldc = 64; colt = 0; }
        const int row0 = u.pm * 256 + wr * 64 + fr;
        if (mode == 3) {
            if (wc < 2) {
#pragma unroll
                for (int ai = 0; ai < 2; ++ai)
#pragma unroll
                    for (int m = 0; m < 4; ++m) { float* rp = DT + (size_t)(row0 + ai * 128 + m * 16) * 64 + wc * 32 + 8 * fq;
                        *(f32x4*)rp = acc[ai][0][m][0]; *(f32x4*)(rp + 4) = acc[ai][0][m][1]; }
            }
            return;
        }
        const int col0 = colt + wc * 32 + 8 * fq;
#define INPROJ_WALK(...) \
        _Pragma("unroll") for (int ai = 0; ai < 2; ++ai) _Pragma("unroll") for (int m = 0; m < 4; ++m) { bf16_t* rowp = O + (size_t)(row0 + ai * 128 + m * 16) * ldc + col0; \
            _Pragma("unroll") for (int bj = 0; bj < 2; ++bj) { f32x4 v0 = acc[ai][bj][m][0], v1 = acc[ai][bj][m][1]; __VA_ARGS__ \
                u32x4 w; w.x = cvt_pk_bf16(v0[0], v0[1]); w.y = cvt_pk_bf16(v0[2], v0[3]); w.z = cvt_pk_bf16(v1[0], v1[1]); w.w = cvt_pk_bf16(v1[2], v1[3]); \
                *(u32x4*)(rowp + bj * 128) = w; } asm volatile("" ::: "memory"); }
        if (mode == 0) { INPROJ_WALK() }
        else if (mode == 1) { INPROJ_WALK(_Pragma("unroll") for (int e = 0; e < 4; ++e) { v0[e] = silu_f(v0[e]); v1[e] = silu_f(v1[e]); }) }
        else { INPROJ_WALK({ const f32x4 b0 = *(const f32x4*)(b_merge + col0 + bj * 128), b1 = *(const f32x4*)(b_merge + col0 + bj * 128 + 4);
                 _Pragma("unroll") for (int e = 0; e < 4; ++e) { v0[e] = sigm_f(v0[e] + b0[e]); v1[e] = sigm_f(v1[e] + b1[e]); } }) }
#undef INPROJ_WALK
    }
};
#define EPI_WALK(...) \
    const int row0_ = u.pm * 256 + wr * 64 + fr, col0_ = u.pn * 256 + wc * 32 + 8 * fq; \
    _Pragma("unroll") for (int ai = 0; ai < 2; ++ai) _Pragma("unroll") for (int m = 0; m < 4; ++m) { const size_t row = (size_t)(row0_ + ai * 128 + m * 16); \
    _Pragma("unroll") for (int bj = 0; bj < 2; ++bj) { const int col = col0_ + bj * 128; const f32x4 v0 = acc[ai][bj][m][0], v1 = acc[ai][bj][m][1]; __VA_ARGS__ } asm volatile("" ::: "memory"); }

struct EpiPool {
    static constexpr bool PERM = true, AFTER_DRAIN = false;
    bf16_t* YP; const bf16_t* SZP; const float* pscale;
    __device__ __forceinline__ void operator()(const f32x4 (&acc)[2][2][4][2], const pg8::Unit& u, int wr, int wc, int, int) const { const int ln_ = fresh_lane(), fr = ln_ & 15, fq = ln_ >> 4;
        EPI_WALK({ const f32x4 s0 = *(const f32x4*)(pscale + col), s1 = *(const f32x4*)(pscale + col + 4); float z[8]; unpack8(*(const u32x4*)(SZP + row * 1024 + col), z);
            float o[8]; o[0] = v0[0] * s0[0] * z[0]; o[1] = v0[1] * s0[1] * z[1]; o[2] = v0[2] * s0[2] * z[2]; o[3] = v0[3] * s0[3] * z[3];
            o[4] = v1[0] * s1[0] * z[4]; o[5] = v1[1] * s1[1] * z[5]; o[6] = v1[2] * s1[2] * z[6]; o[7] = v1[3] * s1[3] * z[7];
            *(u32x4*)(YP + row * 1024 + col) = pack8(o); })
    }
};
struct EpiM1 {
    static constexpr bool PERM = true, AFTER_DRAIN = false;
    float* TMP; const bf16_t* GATES;
    __device__ __forceinline__ void operator()(const f32x4 (&acc)[2][2][4][2], const pg8::Unit& u, int wr, int wc, int, int) const { const int ln_ = fresh_lane(), fr = ln_ & 15, fq = ln_ >> 4;
        EPI_WALK({ float gt[8]; unpack8(*(const u32x4*)(GATES + row * 2048 + col), gt);
            f32x4 o0, o1; o0[0] = v0[0] * gt[0]; o0[1] = v0[1] * gt[1]; o0[2] = v0[2] * gt[2]; o0[3] = v0[3] * gt[3]; o1[0] = v1[0] * gt[4]; o1[1] = v1[1] * gt[5]; o1[2] = v1[2] * gt[6]; o1[3] = v1[3] * gt[7];
            *(f32x4*)(TMP + row * 1024 + col) = o0; *(f32x4*)(TMP + row * 1024 + col + 4) = o1; })
    }
};
struct EpiM2 {
    static constexpr bool PERM = true, AFTER_DRAIN = false;
    const float* TMP; const bf16_t* GATES; bf16_t* MRG;
    __device__ __forceinline__ void operator()(const f32x4 (&acc)[2][2][4][2], const pg8::Unit& u, int wr, int wc, int, int) const { const int ln_ = fresh_lane(), fr = ln_ & 15, fq = ln_ >> 4;
        EPI_WALK({ float gt[8]; unpack8(*(const u32x4*)(GATES + row * 2048 + 1024 + col), gt);
            const f32x4 t0 = *(const f32x4*)(TMP + row * 1024 + col), t1 = *(const f32x4*)(TMP + row * 1024 + col + 4);
            float o[8]; o[0] = t0[0] + v0[0] * gt[0]; o[1] = t0[1] + v0[1] * gt[1]; o[2] = t0[2] + v0[2] * gt[2]; o[3] = t0[3] + v0[3] * gt[3];
            o[4] = t1[0] + v1[0] * gt[4]; o[5] = t1[1] + v1[1] * gt[5]; o[6] = t1[2] + v1[2] * gt[6]; o[7] = t1[3] + v1[3] * gt[7];
            *(u32x4*)(MRG + row * 1024 + col) = pack8(o); })
    }
};
struct EpiF32 {
    static constexpr bool PERM = true, AFTER_DRAIN = false;
    float* O;
    __device__ __forceinline__ void operator()(const f32x4 (&acc)[2][2][4][2], const pg8::Unit& u, int wr, int wc, int, int) const { const int ln_ = fresh_lane(), fr = ln_ & 15, fq = ln_ >> 4;
        EPI_WALK({ *(f32x4*)(O + row * 1024 + col) = v0; *(f32x4*)(O + row * 1024 + col + 4) = v1; })
    }
};
DI void transpose_item(const float* W, int K, int N, bf16_t* WT, int ldo, int row_off, LAS float* scr, int item, int lane) {
    const int nblk = N / 32, kb = item / nblk, nb = item % nblk, k0 = 64 * kb, n0 = 32 * nb;
#pragma unroll 8
    for (int i = 0; i < 32; ++i) { const int kk = 2 * i + (lane >> 5); scr[kk * 33 + (lane & 31)] = W[(size_t)(k0 + kk) * N + n0 + (lane & 31)]; }
    asm volatile("s_waitcnt lgkmcnt(0)" ::: "memory");
    const int c = lane & 7;
#pragma unroll
    for (int j = 0; j < 4; ++j) { const int n = (lane >> 3) + 8 * j; const LAS float* s = scr + (8 * c) * 33 + n;
        u32x4 o; o.x = cvt_pk_bf16(s[0 * 33], s[1 * 33]); o.y = cvt_pk_bf16(s[2 * 33], s[3 * 33]); o.z = cvt_pk_bf16(s[4 * 33], s[5 * 33]); o.w = cvt_pk_bf16(s[6 * 33], s[7 * 33]);
        *(u32x4*)(WT + (size_t)(row_off + n0 + n) * ldo + k0 + 8 * c) = o; }
    asm volatile("s_waitcnt lgkmcnt(0)" ::: "memory");
}
DI void mod_item(LAS unsigned char* lds, const float* c, const float* c_ctx, const float* w_ada, const float* b_ada, float* MOD, int item, int tid) {
    LAS float* sS = (LAS float*)lds;
    LAS float* sP = (LAS float*)(lds + 17 * 1024 * 4);
    for (int i = tid; i < 17 * 1024; i += NTHR) { const float v = i < 16 * 1024 ? c[i] : c_ctx[i - 16 * 1024]; sS[i] = silu_f(v); }
    __syncthreads();
    const int col = tid & 63, kseg = tid >> 6, n = item * 64 + col;
    float acc[17];
#pragma unroll
    for (int r = 0; r < 17; ++r) acc[r] = 0.f;
    for (int k = kseg * 128; k < kseg * 128 + 128; ++k) { const float w = w_ada[(size_t)k * 3072 + n];
#pragma unroll
        for (int r = 0; r < 17; ++r) acc[r] += sS[r * 1024 + k] * w; }
#pragma unroll
    for (int r = 0; r < 17; ++r) sP[(kseg * 17 + r) * 64 + col] = acc[r];
    __syncthreads();
    for (int i = tid; i < 17 * 64; i += NTHR) { const int r = i >> 6, cc = i & 63; float s = b_ada[item * 64 + cc];
#pragma unroll
        for (int q = 0; q < 8; ++q) s += sP[(q * 17 + r) * 64 + cc];
        MOD[r * 3072 + item * 64 + cc] = s; }
    __syncthreads();
}
DI void modnorm_row(const float* xrow, const float* npre, const float* mod, bf16_t* orow, int lane) {
    f32x4 v[4]; float ss = 0.f;
#pragma unroll
    for (int j = 0; j < 4; ++j) { v[j] = *(const f32x4*)(xrow + 4 * lane + 256 * j); ss += (v[j].x * v[j].x + v[j].y * v[j].y) + (v[j].z * v[j].z + v[j].w * v[j].w); }
    const float rstd = rsqrtf(wave_sum(ss, lane) * (1.f / 1024.f) + EPS);
#pragma unroll
    for (int j = 0; j < 4; ++j) { const int c0 = 4 * lane + 256 * j; const f32x4 w = *(const f32x4*)(npre + c0), sh = *(const f32x4*)(mod + c0), sc = *(const f32x4*)(mod + 1024 + c0);
        f32x4 o;
#pragma unroll
        for (int e = 0; e < 4; ++e) o[e] = v[j][e] * rstd * w[e] * (1.f + sc[e]) + sh[e];
        u32x2 p; p.x = cvt_pk_bf16(o[0], o[1]); p.y = cvt_pk_bf16(o[2], o[3]); *(u32x2*)(orow + c0) = p; }
}
DI void final_row(float* yrow, const float* xrow, const float* npost, const float* gate, int lane) {
    f32x4 v[4]; float ss = 0.f;
#pragma unroll
    for (int j = 0; j < 4; ++j) { v[j] = *(const f32x4*)(yrow + 4 * lane + 256 * j); ss += (v[j].x * v[j].x + v[j].y * v[j].y) + (v[j].z * v[j].z + v[j].w * v[j].w); }
    const float rstd = rsqrtf(wave_sum(ss, lane) * (1.f / 1024.f) + EPS);
#pragma unroll
    for (int j = 0; j < 4; ++j) { const int c0 = 4 * lane + 256 * j; const f32x4 w = *(const f32x4*)(npost + c0), g = *(const f32x4*)(gate + c0), x = *(const f32x4*)(xrow + c0);
        f32x4 o;
#pragma unroll
        for (int e = 0; e < 4; ++e) o[e] = x[e] + g[e] * (v[j][e] * rstd * w[e]);
        *(f32x4*)(yrow + c0) = o; }
}
DI void gnorm_item(bf16_t* yf, const bf16_t* yb, const bf16_t* szs, const float* w, int lane) {
    float a[8], b[8], z[8], u[8]; unpack8(*(const u32x4*)(yf + lane * 8), a); unpack8(*(const u32x4*)(yb + lane * 8), b); unpack8(*(const u32x4*)(szs + lane * 8), z);
    float ss = 0.f;
#pragma unroll
    for (int e = 0; e < 8; ++e) { u[e] = (a[e] + b[e]) * z[e]; ss += u[e] * u[e]; }
    const float r = rsqrtf(wave_sum(ss, lane) * (1.f / 512.f) + EPS);
    const f32x4 w0 = *(const f32x4*)(w + lane * 8), w1 = *(const f32x4*)(w + lane * 8 + 4);
    float o[8];
#pragma unroll
    for (int e = 0; e < 4; ++e) { o[e] = u[e] * r * w0[e]; o[4 + e] = u[4 + e] * r * w1[e]; }
    *(u32x4*)(yf + lane * 8) = pack8(o);
}

constexpr int RS = 272;
DI void conv_xs_item(LAS unsigned char* lds, const bf16_t* src, int L, int c, int hb, bf16_t* dst_tile, const float* conv_w, const float* conv_b, int tid) {
    const int cp = tid & 31, tq = tid >> 5, ch = hb * 64 + 2 * cp;
    float w0[4], w1[4];
#pragma unroll
    for (int k = 0; k < 4; ++k) { w0[k] = conv_w[k * 3072 + ch]; w1[k] = conv_w[k * 3072 + ch + 1]; }
    const float b0 = conv_b[ch], b1 = conv_b[ch + 1];
    const int t0 = c * 128 + tq * 8 - 2;
    float x0[11], x1[11];
#pragma unroll
    for (int r = 0; r < 11; ++r) { const int t = t0 + r; unsigned v = 0u; if (t >= 0 && t < L) v = *(const unsigned*)(src + (size_t)t * 3072 + ch); x0[r] = bflo(v); x1[r] = bfhi(v); }
    float o0[8], o1[8];
#pragma unroll
    for (int u = 0; u < 8; ++u) { float s0 = b0, s1 = b1;
#pragma unroll
        for (int k = 0; k < 4; ++k) { s0 += w0[k] * x0[u + k]; s1 += w1[k] * x1[u + k]; }
        o0[u] = silu_f(s0); o1[u] = silu_f(s1); }
    *(LAS u32x4*)(lds + (2 * cp) * RS + tq * 16) = pack8(o0);
    *(LAS u32x4*)(lds + (2 * cp + 1) * RS + tq * 16) = pack8(o1);
    __syncthreads();
    { const int row = tid >> 3, cb = (tid & 7) * 32;
      const u32x4 a = *(const LAS u32x4*)(lds + row * RS + cb), b = *(const LAS u32x4*)(lds + row * RS + cb + 16);
      *(u32x4*)((char*)dst_tile + tid * 32) = a; *(u32x4*)((char*)dst_tile + tid * 32 + 16) = b; }
    __syncthreads();
}
DI void conv_bc_item(LAS unsigned char* lds, const bf16_t* src, int L, int c, int g, bf16_t* bt_tile, bf16_t* cg_rows, bf16_t* gt_tile, const float* conv_w, const float* conv_b, int tid) {
    LAS unsigned char* sB = lds; LAS unsigned char* sC = lds + 128 * RS;
    {
        const int mat = tid >> 8, tt = tid & 255, cp = tt & 63, tq = tt >> 6, ch = 2048 + mat * 512 + g * 128 + 2 * cp;
        LAS unsigned char* sM = mat ? sC : sB;
        float w0[4], w1[4];
#pragma unroll
        for (int k = 0; k < 4; ++k) { w0[k] = conv_w[k * 3072 + ch]; w1[k] = conv_w[k * 3072 + ch + 1]; }
        const float b0 = conv_b[ch], b1 = conv_b[ch + 1];
        const int t0 = c * 128 + tq * 32 - 2;
        float xa[4], xb[4];
#pragma unroll
        for (int r = 0; r < 3; ++r) { const int t = t0 + r; unsigned v = 0u; if (t >= 0 && t < L) v = *(const unsigned*)(src + (size_t)t * 3072 + ch); xa[r] = bflo(v); xb[r] = bfhi(v); }
#pragma unroll 8
        for (int u = 0; u < 32; ++u) { const int t = t0 + u + 3; unsigned v = 0u; if (t >= 0 && t < L) v = *(const unsigned*)(src + (size_t)t * 3072 + ch); xa[3] = bflo(v); xb[3] = bfhi(v);
            float s0 = b0, s1 = b1;
#pragma unroll
            for (int k = 0; k < 4; ++k) { s0 += w0[k] * xa[k]; s1 += w1[k] * xb[k]; }
            *(LAS unsigned*)(sM + (tq * 32 + u) * RS + cp * 4) = cvt_pk_bf16(silu_f(s0), silu_f(s1));
            xa[0] = xa[1]; xa[1] = xa[2]; xa[2] = xa[3]; xb[0] = xb[1]; xb[1] = xb[2]; xb[2] = xb[3]; }
    }
    __syncthreads();
    if (cg_rows) { const int row = tid >> 2, cb = (tid & 3) * 64;
#pragma unroll
        for (int q = 0; q < 4; ++q) *(u32x4*)((char*)(cg_rows + (size_t)row * 512) + cb + q * 16) = *(const LAS u32x4*)(sC + row * RS + cb + q * 16); }
    { const int n = tid >> 2, j0 = (tid & 3) * 32;
#pragma unroll
      for (int q = 0; q < 4; ++q) { unsigned h[8];
#pragma unroll
          for (int e = 0; e < 8; ++e) h[e] = *(const LAS unsigned short*)(sB + (j0 + q * 8 + e) * RS + n * 2);
          u32x4 o; o.x = h[0] | (h[1] << 16); o.y = h[2] | (h[3] << 16); o.z = h[4] | (h[5] << 16); o.w = h[6] | (h[7] << 16);
          *(u32x4*)(bt_tile + (size_t)n * 128 + j0 + q * 8) = o; } }
    if (gt_tile) { const int wid = tid >> 6, lane = tid & 63, fr = lane & 15, fq = lane >> 4;
        f32x4 acc[8];
#pragma unroll
        for (int jb = 0; jb < 8; ++jb) acc[jb] = (f32x4){0.f, 0.f, 0.f, 0.f};
#pragma unroll
        for (int ks = 0; ks < 4; ++ks) { const bf16x8 cf = *(const LAS bf16x8*)(sC + (16 * wid + fr) * RS + (ks * 32 + fq * 8) * 2);
#pragma unroll
            for (int jb = 0; jb < 8; ++jb) { const bf16x8 bfr = *(const LAS bf16x8*)(sB + (jb * 16 + fr) * RS + (ks * 32 + fq * 8) * 2); acc[jb] = MFMA16(bfr, cf, acc[jb]); } }
#pragma unroll
        for (int jb = 0; jb < 8; ++jb) { u32x2 p; p.x = cvt_pk_bf16(acc[jb][0], acc[jb][1]); p.y = cvt_pk_bf16(acc[jb][2], acc[jb][3]);
            *(u32x2*)(gt_tile + (size_t)(16 * wid + fr) * 128 + jb * 16 + fq * 4) = p; } }
    __syncthreads();
}
DI void dt_item(LAS unsigned char* lds, const float* dtr, int L, int c, float* dtv, float* acs, size_t dir_stride, const float* dt_bias, const float* a_log, int tid) {
    LAS float* sTot = (LAS float*)lds;
    const int col = tid & 63, seg = tid >> 6, dir = col >> 5, h = col & 31;
    const float bias = dt_bias[col], A = -__expf(a_log[col]);
    float dtl[16], cs[16];
#pragma unroll
    for (int u = 0; u < 16; ++u) { const float x = dtr[(size_t)(c * 128 + seg * 16 + u) * 64 + col] + bias; dtl[u] = x > 20.f ? x : log1pf(expf(x)); }
    float run = 0.f;
    if (dir == 0) {
#pragma unroll
        for (int u = 0; u < 16; ++u) { run += dtl[u] * A; cs[u] = run; }
    } else {
#pragma unroll
        for (int u = 15; u >= 0; --u) { run += dtl[u] * A; cs[u] = run; }
    }
    sTot[seg * 64 + col] = run;
    __syncthreads();
    float off = 0.f;
#pragma unroll
    for (int s = 0; s < 8; ++s) { const float v = sTot[s * 64 + col]; if (dir == 0 ? (s < seg) : (s > seg)) off += v; }
    const size_t o = (size_t)dir * dir_stride + (size_t)h * L + c * 128 + seg * 16;
#pragma unroll
    for (int q = 0; q < 4; ++q) { *(f32x4*)(dtv + o + 4 * q) = (f32x4){dtl[4 * q], dtl[4 * q + 1], dtl[4 * q + 2], dtl[4 * q + 3]};
        *(f32x4*)(acs + o + 4 * q) = (f32x4){cs[4 * q] + off, cs[4 * q + 1] + off, cs[4 * q + 2] + off, cs[4 * q + 3] + off}; }
    __syncthreads();
}
DI void pool_item(LAS unsigned char* lds, const bf16_t* v, bf16_t* dd, int r, int gi, int tid) {
    LAS float* sV = (LAS float*)lds;
    const int k = 2 << gi, lo = k >> 1, hi = k - 1 - lo;
    const int c8 = tid & 31, wq = tid >> 5, ch = gi * 256 + c8 * 8;
    const int r_lo = max(r - lo, 0), r_hi = min(r + hi + 1, 64);
    const float inv_r = 1.f / (float)(r_hi - r_lo);
    float acc[4][8]; u32x4 ctr[4];
#pragma unroll
    for (int q = 0; q < 4; ++q) { ctr[q] = (u32x4){0u, 0u, 0u, 0u};
#pragma unroll
        for (int e = 0; e < 8; ++e) acc[q][e] = 0.f; }
    for (int rr = r_lo; rr < r_hi; ++rr) {
#pragma unroll
        for (int q = 0; q < 4; ++q) { const u32x4 x = *(const u32x4*)(v + ((size_t)(rr * 64 + wq * 4 + q) * 1024 + ch)); float f[8]; unpack8(x, f);
#pragma unroll
            for (int e = 0; e < 8; ++e) acc[q][e] += f[e];
            if (rr == r) ctr[q] = x; } }
#pragma unroll
    for (int q = 0; q < 4; ++q) { LAS float* p = sV + (wq * 4 + q) * 260 + c8 * 8;
        *(LAS f32x4*)p = (f32x4){acc[q][0] * inv_r, acc[q][1] * inv_r, acc[q][2] * inv_r, acc[q][3] * inv_r};
        *(LAS f32x4*)(p + 4) = (f32x4){acc[q][4] * inv_r, acc[q][5] * inv_r, acc[q][6] * inv_r, acc[q][7] * inv_r}; }
    __syncthreads();
#pragma unroll
    for (int q = 0; q < 4; ++q) { const int w = wq * 4 + q, w_lo = max(w - lo, 0), w_hi = min(w + hi + 1, 64);
        f32x4 s0 = (f32x4){0.f, 0.f, 0.f, 0.f}, s1 = s0;
        for (int ww = w_lo; ww < w_hi; ++ww) { const LAS float* p = sV + ww * 260 + c8 * 8; s0 += *(const LAS f32x4*)p; s1 += *(const LAS f32x4*)(p + 4); }
        const float inv_w = 1.f / (float)(w_hi - w_lo); float cv[8]; unpack8(ctr[q], cv); float o[8];
#pragma unroll
        for (int e = 0; e < 4; ++e) { o[e] = s0[e] * inv_w - cv[e]; o[4 + e] = s1[e] * inv_w - cv[4 + e]; }
        *(u32x4*)(dd + ((size_t)(r * 64 + w) * 1024 + ch)) = pack8(o); }
    __syncthreads();
}
DI void ssd_phase(LAS unsigned char* lds, const unsigned char* ws, const float* d_skip_p, int b0, int vcu, int G, int tid_in) {
    int tid_l = tid_in; asm volatile("" : "+v"(tid_l));
    const int tid = tid_l, wid = __builtin_amdgcn_readfirstlane(tid >> 6), lane = tid & 63, fr = lane & 15, fq = lane >> 4;
    LAS unsigned char* sXT = lds; LAS unsigned char* sHb = lds + 64 * RS;
    LAS float* sDT = (LAS float*)(lds + 2 * 64 * RS); LAS float* sACS = sDT + 128; LAS float* sW = sDT + 256;
    for (int item = vcu; item < NB * 64; item += G) {
        const int dir = item & 1, hh = (item >> 1) & 7, g = (item >> 4) & 3, bl = item >> 6, h = g * 8 + hh, bg = b0 + bl;
        const float dsk = dir == 0 ? d_skip_p[h] : 0.f;
        const unsigned yoff = (unsigned)(dir == 0 ? WS_YF : WS_YB);
        f32x4 accH[4];
#pragma unroll
        for (int pb = 0; pb < 4; ++pb) accH[pb] = (f32x4){0.f, 0.f, 0.f, 0.f};
        u32x4 xt0 = (u32x4){0u, 0u, 0u, 0u}, xt1 = xt0; bf16x8 bt[4], gt[4], cgf[4]; float r_dt = 0.f, r_acs = 0.f, r_alast = 0.f;
#pragma unroll
        for (int ks = 0; ks < 4; ++ks) { bt[ks] = (bf16x8){0, 0, 0, 0, 0, 0, 0, 0}; gt[ks] = bt[ks]; cgf[ks] = bt[ks]; }
        const unsigned lrow = (unsigned)(wid * 16 + fr);
#define SSD_LOAD_XT_DA(s_) do { const int s__ = (s_); unsigned xo, dof, aof; \
        if (s__ < 2) { const int cc = dir == 0 ? s__ : 1 - s__; xo = (unsigned)WS_CXT + (unsigned)((bg * 2 + cc) * 2048 + h * 64) * 256u; const unsigned o = ((unsigned)((dir * 16 + bg) * 32 + h) * 256u + cc * 128) * 4u; dof = (unsigned)WS_CDTV + o; aof = (unsigned)WS_CACS + o; } \
        else { const int c_ = dir == 0 ? s__ - 2 : 33 - s__; xo = (unsigned)WS_XT + (unsigned)((bl * 32 + c_) * 2048 + h * 64) * 256u; const unsigned o = ((unsigned)((dir * NB + bl) * 32 + h) * 4096u + c_ * 128) * 4u; dof = (unsigned)WS_DTV + o; aof = (unsigned)WS_ACS + o; } \
        xt0 = *(const u32x4*)(ws + (xo + tid * 32)); xt1 = *(const u32x4*)(ws + (xo + tid * 32 + 16)); \
        if (tid < 128) { r_dt = *(const float*)(ws + (dof + tid * 4)); r_acs = *(const float*)(ws + (aof + tid * 4)); } r_alast = *(const float*)(ws + (aof + (dir == 0 ? 127 * 4 : 0))); } while (0)
#define SSD_LOAD_BT(s_) do { const int s__ = (s_); unsigned bo; \
        if (s__ < 2) { const int cc = dir == 0 ? s__ : 1 - s__; bo = (unsigned)WS_CBT + (unsigned)((bg * 2 + cc) * 512 + g * 128) * 256u; } \
        else { const int c_ = dir == 0 ? s__ - 2 : 33 - s__; bo = (unsigned)WS_BT + (unsigned)((bl * 32 + c_) * 512 + g * 128) * 256u; } \
        bo += lrow * 256u + fq * 16; \
        _Pragma("unroll") for (int ks = 0; ks < 4; ++ks) bt[ks] = *(const bf16x8*)(ws + (bo + ks * 64)); } while (0)
#define SSD_LOAD_GT_CG(s_) do { const int c_ = dir == 0 ? (s_) - 2 : 33 - (s_); \
        const unsigned go = (unsigned)WS_GT + (unsigned)(((bl * 32 + c_) * 4 + g) * 128) * 256u + lrow * 256u + fq * 16; \
        const unsigned co = (unsigned)WS_CG + ((unsigned)(bl * 4096 + c_ * 128) + lrow) * 1024u + g * 256 + fq * 16; \
        _Pragma("unroll") for (int ks = 0; ks < 4; ++ks) { gt[ks] = *(const bf16x8*)(ws + (go + ks * 64)); cgf[ks] = *(const bf16x8*)(ws + (co + ks * 64)); } } while (0)
        SSD_LOAD_XT_DA(0); SSD_LOAD_BT(0);
        for (int s = 0; s < 34; ++s) {
            { const int row = tid >> 3, cb = (tid & 7) * 32; *(LAS u32x4*)(sXT + row * RS + cb) = xt0; *(LAS u32x4*)(sXT + row * RS + cb + 16) = xt1; }
#pragma unroll
            for (int pb = 0; pb < 4; ++pb) { u32x2 p; p.x = cvt_pk_bf16(accH[pb][0], accH[pb][1]); p.y = cvt_pk_bf16(accH[pb][2], accH[pb][3]);
                *(LAS u32x2*)(sHb + (pb * 16 + fr) * RS + (wid * 16 + fq * 4) * 2) = p; }
            const float alast = r_alast;
            if (tid < 128) { sDT[tid] = r_dt; sACS[tid] = r_acs; sW[tid] = r_dt * __expf(alast - r_acs); }
            __syncthreads();
            if (s + 1 < 34) SSD_LOAD_XT_DA(s + 1);
            if (s >= 2) {
                const int c_ = dir == 0 ? s - 2 : 33 - s;
                f32x4 accO[4], accD[4];
#pragma unroll
                for (int pb = 0; pb < 4; ++pb) { accO[pb] = (f32x4){0.f, 0.f, 0.f, 0.f}; accD[pb] = accO[pb]; }
                int i_l = wid * 16 + fr; asm volatile("" : "+v"(i_l)); const int i = i_l;
                const float acs_i = sACS[i];
#pragma unroll
                for (int ks = 0; ks < 4; ++ks)
#pragma unroll
                    for (int pb = 0; pb < 4; ++pb) { const bf16x8 a = *(const LAS bf16x8*)(sHb + (pb * 16 + fr) * RS + (ks * 32 + fq * 8) * 2); accO[pb] = MFMA16(a, cgf[ks], accO[pb]); }
#pragma unroll
                for (int ks = 0; ks < 4; ++ks) {
                    const bool need = dir == 0 ? (ks <= (wid >> 1)) : (ks >= (wid >> 1));
                    if (need) {
                        const int j0 = ks * 32 + fq * 8;
                        const f32x4 a0 = *(const LAS f32x4*)(sACS + j0), a1 = *(const LAS f32x4*)(sACS + j0 + 4), d0 = *(const LAS f32x4*)(sDT + j0), d1 = *(const LAS f32x4*)(sDT + j0 + 4);
                        float gv[8]; unpack8(__builtin_bit_cast(u32x4, gt[ks]), gv); float mv[8];
#pragma unroll
                        for (int e = 0; e < 8; ++e) { const int j = j0 + e; const float aj = e < 4 ? a0[e & 3] : a1[e & 3], dj = e < 4 ? d0[e & 3] : d1[e & 3];
                            const bool valid = dir == 0 ? (j <= i) : (j >= i);
                            float val = gv[e] * __expf(acs_i - aj) * dj; if (j == i) val += dsk;
                            mv[e] = valid ? val : 0.f; }
                        const bf16x8 mf = __builtin_bit_cast(bf16x8, pack8(mv));
#pragma unroll
                        for (int pb = 0; pb < 4; ++pb) { const bf16x8 a = *(const LAS bf16x8*)(sXT + (pb * 16 + fr) * RS + j0 * 2); accD[pb] = MFMA16(a, mf, accD[pb]); }
                    }
                }
                const float ei = __expf(acs_i);
                unsigned char* yrow = (unsigned char*)ws + (yoff + ((unsigned)(bl * 4096 + c_ * 128 + i) * 2048u + h * 64 + fq * 4) * 2u);
#pragma unroll
                for (int pb = 0; pb < 4; ++pb) { u32x2 p; p.x = cvt_pk_bf16(accD[pb][0] + ei * accO[pb][0], accD[pb][1] + ei * accO[pb][1]); p.y = cvt_pk_bf16(accD[pb][2] + ei * accO[pb][2], accD[pb][3] + ei * accO[pb][3]);
                    *(u32x2*)(yrow + pb * 32) = p; }
            }
            if (s + 1 < 34 && s + 1 >= 2) SSD_LOAD_GT_CG(s + 1);
            { const float dec = __expf(alast);
#pragma unroll
              for (int pb = 0; pb < 4; ++pb) accH[pb] *= dec;
#pragma unroll
              for (int ks = 0; ks < 4; ++ks) { const int j0 = ks * 32 + fq * 8;
                  const f32x4 w0 = *(const LAS f32x4*)(sW + j0), w1 = *(const LAS f32x4*)(sW + j0 + 4);
                  float bv[8]; unpack8(__builtin_bit_cast(u32x4, bt[ks]), bv);
#pragma unroll
                  for (int e = 0; e < 4; ++e) { bv[e] *= w0[e]; bv[4 + e] *= w1[e]; }
                  const bf16x8 bw = __builtin_bit_cast(bf16x8, pack8(bv));
#pragma unroll
                  for (int pb = 0; pb < 4; ++pb) { const bf16x8 xf = *(const LAS bf16x8*)(sXT + (pb * 16 + fr) * RS + j0 * 2); accH[pb] = MFMA16(bw, xf, accH[pb]); } } }
            if (s + 1 < 34) SSD_LOAD_BT(s + 1);
            __syncthreads();
        }
#undef SSD_LOAD_XT_DA
#undef SSD_LOAD_BT
#undef SSD_LOAD_GT_CG
    }
}

struct Args { const float* in[21]; float* out; unsigned char* ws; int ph_lo, ph_hi; };
static_assert(sizeof(Args) == 23 * 8 + 8, "Args has no padding");


#define IN_(k) (args.in[k])
#define x_in IN_(0)
#define c_in IN_(1)
#define ctx IN_(2)
#define c_ctx IN_(3)
#define w_ada IN_(4)
#define b_ada IN_(5)
#define norm_pre IN_(6)
#define norm_post IN_(7)
#define w_in IN_(8)
#define b_merge IN_(9)
#define pool_w IN_(10)
#define pool_scale IN_(11)
#define conv_w IN_(12)
#define conv_b IN_(13)
#define dt_bias IN_(14)
#define a_log IN_(15)
#define d_skip IN_(16)
#define ssd_norm IN_(17)
#define w_proj_pool IN_(18)
#define w_proj_ssd IN_(19)
#define w_out IN_(20)
#define out_p (args.out)
#define WSB(off) ((bf16_t*)(ws_l + (off)))
#define WSF(off) ((float*)(ws_l + (off)))
#define WIN WSB(WS_WIN)
#define WPP WSB(WS_WPP)
#define WPS WSB(WS_WPS)
#define WO WSB(WS_WO)
#define PW WSB(WS_PW)
#define MOD WSF(WS_MOD)
#define HC WSB(WS_HC)
#define CXBC WSB(WS_CXBC)
#define CXT WSB(WS_CXT)
#define CBT WSB(WS_CBT)
#define CDT WSF(WS_CDT)
#define CDTV WSF(WS_CDTV)
#define CACS WSF(WS_CACS)
#define HX WSB(WS_HX)
#define V WSB(WS_V)
#define SZS WSB(WS_SZS)
#define GATES WSB(WS_GATES)
#define XBC WSB(WS_XBC)
#define DTR WSF(WS_DTR)
#define DTV WSF(WS_DTV)
#define ACS WSF(WS_ACS)
#define XT WSB(WS_XT)
#define CG WSB(WS_CG)
#define BT WSB(WS_BT)
#define GT WSB(WS_GT)
#define YF WSB(WS_YF)
#define YP WSB(WS_YP)
#define YB WSB(WS_YB)
#define MRG WSB(WS_MRG)
__global__ void __launch_bounds__(NTHR, 2) fwd_megakernel(Args args) {
    extern __shared__ __attribute__((aligned(16))) unsigned char lds_raw[];
    cg::grid_group grid = cg::this_grid();
    LAS unsigned char* lds = (LAS unsigned char*)lds_raw;
    const int G = gridDim.x, bx = blockIdx.x, NGW = G * 8, wave_k = __builtin_amdgcn_readfirstlane((int)threadIdx.x >> 6);
    const int lo = args.ph_lo, hi = args.ph_hi;
    int ph = 0;
#define PHASE_BEGIN if (lo <= ph && ph < hi) { int tid_l = wave_k * 64 + fresh_lane(); asm volatile("" : "+v"(tid_l)); const int tid = tid_l, lane = tid & 63, wave = wave_k; \
        int vcu_l = (G % 8 == 0) ? (bx % 8) * (G / 8) + bx / 8 : bx; asm volatile("" : "+s"(vcu_l)); const int vcu = vcu_l, gw = vcu * 8 + wave; (void)tid; (void)lane; (void)gw; \
        unsigned char* ws_l = args.ws; asm volatile("" : "+s"(ws_l));
#define PHASE_END } ++ph; if (lo < ph && ph < hi) grid.sync();

    PHASE_BEGIN
        for (int it = vcu; it < 48; it += G) mod_item(lds, c_in, c_ctx, w_ada, b_ada, MOD, it, tid);
        LAS float* scr = (LAS float*)(lds + wave * 16384);
        constexpr int I_IN = 16 * 290, I_PP = 16 * 32, I_PS = 32 * 32, I_O = 16 * 32, I_PW = 4 * 8;
        for (int it = gw; it < I_IN + I_PP + I_PS + I_O + 4 * I_PW; it += NGW) {
            int r = it;
            if (r < I_IN) { transpose_item(w_in, 1024, 9280, WIN, 1024, 0, scr, r, lane); continue; } r -= I_IN;
            if (r < I_PP) { transpose_item(w_proj_pool, 1024, 1024, WPP, 1024, 0, scr, r, lane); continue; } r -= I_PP;
            if (r < I_PS) { transpose_item(w_proj_ssd, 2048, 1024, WPS, 2048, 0, scr, r, lane); continue; } r -= I_PS;
            if (r < I_O) { transpose_item(w_out, 1024, 1024, WO, 1024, 0, scr, r, lane); continue; } r -= I_O;
            { const int gq = r / I_PW; transpose_item(pool_w + (size_t)gq * 65536, 256, 256, PW, 256, gq * 256, scr, r % I_PW, lane); }
        }
    PHASE_END
    PHASE_BEGIN
        for (int m = gw; m < CT; m += NGW) modnorm_row(ctx + (size_t)m * 1024, norm_pre, MOD + 16 * 3072, HC + (size_t)m * 1024, lane);
        for (int m = gw; m < T; m += NGW) modnorm_row(x_in + (size_t)m * 1024, norm_pre, MOD + (m >> 12) * 3072, HX + (size_t)m * 1024, lane);
    PHASE_END
    for (int grp = 0; grp < NGRP; ++grp) {
        const int b0 = grp * NB; const size_t tok0 = (size_t)b0 * SEQ;
        float* outg = out_p + tok0 * 1024;
        bf16_t* SZP = (bf16_t*)outg; bf16_t* DD = (bf16_t*)outg + (size_t)T * 1024;
        PHASE_BEGIN
            if (grp == 0) {
                pg8::Gemm g{HC, WIN + (size_t)24 * 256 * 1024, 1024, 1024, 1024, 0}; pg8::StaticOrder S; S.init(CT, 13 * 256, G, bx);
                EpiInProj E{nullptr, nullptr, nullptr, nullptr, CXBC, CDT, b_merge, 24};
                pg8::gemm_phase<EpiInProj, pg8::StaticOrder, true, true>(lds, g, S, E, tid);
            }
            { pg8::Gemm g{HX, WIN, 1024, 1024, 1024, 0}; pg8::StaticOrder S; S.init(T, INP, G, bx);
              EpiInProj E{V, SZP, SZS, GATES, XBC, DTR, b_merge, 0};
              pg8::gemm_phase<EpiInProj, pg8::StaticOrder, true, true>(lds, g, S, E, tid); }
        PHASE_END
        PHASE_BEGIN
            if (grp == 0) {
                for (int it = vcu; it < 16 * 2 * 32; it += G) { const int hb = it & 31, cc = (it >> 5) & 1, b = it >> 6;
                    conv_xs_item(lds, CXBC + (size_t)b * CTXL * 3072, CTXL, cc, hb, CXT + ((size_t)((b * 2 + cc) * 2048 + hb * 64)) * 128, conv_w, conv_b, tid); }
                for (int it = vcu; it < 16 * 2 * 4; it += G) { const int g = it & 3, cc = (it >> 2) & 1, b = it >> 3;
                    conv_bc_item(lds, CXBC + (size_t)b * CTXL * 3072, CTXL, cc, g, CBT + ((size_t)((b * 2 + cc) * 512 + g * 128)) * 128, nullptr, nullptr, conv_w, conv_b, tid); }
                for (int it = vcu; it < 16 * 2; it += G) { const int cc = it & 1, b = it >> 1;
                    dt_item(lds, CDT + (size_t)b * CTXL * 64, CTXL, cc, CDTV + (size_t)b * 32 * CTXL, CACS + (size_t)b * 32 * CTXL, (size_t)16 * 32 * CTXL, dt_bias, a_log, tid); }
            }
            for (int it = vcu; it < NB * 32 * 32; it += G) { const int hb = it & 31, cc = (it >> 5) & 31, b = it >> 10;
                conv_xs_item(lds, XBC + (size_t)b * SEQ * 3072, SEQ, cc, hb, XT + ((size_t)((b * 32 + cc) * 2048 + hb * 64)) * 128, conv_w, conv_b, tid); }
            for (int it = vcu; it < NB * 32 * 4; it += G) { const int g = it & 3, cc = (it >> 2) & 31, b = it >> 7;
                conv_bc_item(lds, XBC + (size_t)b * SEQ * 3072, SEQ, cc, g, BT + ((size_t)((b * 32 + cc) * 512 + g * 128)) * 128, CG + ((size_t)(b * SEQ + cc * 128)) * 512 + g * 128,
                             GT + ((size_t)(((b * 32 + cc) * 4 + g) * 128)) * 128, conv_w, conv_b, tid); }
            for (int it = vcu; it < NB * 32; it += G) { const int cc = it & 31, b = it >> 5;
                dt_item(lds, DTR + (size_t)b * SEQ * 64, SEQ, cc, DTV + (size_t)b * 32 * SEQ, ACS + (size_t)b * 32 * SEQ, (size_t)NB * 32 * SEQ, dt_bias, a_log, tid); }
            for (int it = vcu; it < NB * 64 * 4; it += G) { const int gi = it & 3, r = (it >> 2) & 63, b = it >> 8;
                pool_item(lds, V + (size_t)b * SEQ * 1024, DD + (size_t)b * SEQ * 1024, r, gi, tid); }
        PHASE_END
        PHASE_BEGIN
            ssd_phase(lds, ws_l, d_skip, b0, vcu, G, tid);
        PHASE_END
        PHASE_BEGIN
            for (int it = gw; it < T * 4; it += NGW) { const int gq = it & 3; const size_t m = (size_t)(it >> 2);
                gnorm_item(YF + m * 2048 + gq * 512, YB + m * 2048 + gq * 512, SZS + m * 2048 + gq * 512, ssd_norm + gq * 512, lane); }
            asm volatile("s_waitcnt vmcnt(0)" ::: "memory"); __syncthreads();
            { pg8::Gemm g{DD, PW, 1024, 256, 256, 256}; pg8::StaticOrder S; S.init(T, 1024, G, bx);
              EpiPool E{YP, SZP, pool_scale};
              pg8::gemm_phase<EpiPool, pg8::StaticOrder, true, true>(lds, g, S, E, tid); }
        PHASE_END
        PHASE_BEGIN
            { pg8::Gemm g{YP, WPP, 1024, 1024, 1024, 0}; pg8::StaticOrder S; S.init(T, 1024, G, bx);
              EpiM1 E{outg, GATES};
              pg8::gemm_phase<EpiM1, pg8::StaticOrder, true, true>(lds, g, S, E, tid); }
            asm volatile("s_waitcnt vmcnt(0)" ::: "memory"); __syncthreads();
            { pg8::Gemm g{YF, WPS, 2048, 2048, 2048, 0}; pg8::StaticOrder S; S.init(T, 1024, G, bx);
              EpiM2 E{outg, GATES, MRG};
              pg8::gemm_phase<EpiM2, pg8::StaticOrder, true, true>(lds, g, S, E, tid); }
        PHASE_END
        PHASE_BEGIN
            { pg8::Gemm g{MRG, WO, 1024, 1024, 1024, 0}; pg8::StaticOrder S; S.init(T, 1024, G, bx);
              EpiF32 E{outg};
              pg8::gemm_phase<EpiF32, pg8::StaticOrder, true, true>(lds, g, S, E, tid); }
        PHASE_END
        PHASE_BEGIN
            for (int m = gw; m < T; m += NGW) { const size_t row = tok0 + m; final_row(out_p + row * 1024, x_in + row * 1024, norm_post, MOD + (row >> 12) * 3072 + 2048, lane); }
            if (grp + 1 < NGRP) for (int m = gw; m < T; m += NGW) { const size_t row = tok0 + T + m; modnorm_row(x_in + row * 1024, norm_pre, MOD + (row >> 12) * 3072, HX + (size_t)m * 1024, lane); }
        PHASE_END
    }
#undef PHASE_BEGIN
#undef PHASE_END
}

#undef x_in
#undef c_in
#undef ctx
#undef c_ctx
#undef w_ada
#undef b_ada
#undef norm_pre
#undef norm_post
#undef w_in
#undef b_merge
#undef pool_w
#undef pool_scale
#undef conv_w
#undef conv_b
#undef dt_bias
#undef a_log
#undef d_skip
#undef ssd_norm
#undef w_proj_pool
#undef w_proj_ssd
#undef w_out
#undef out_p
#undef WIN
#undef WPP
#undef WPS
#undef WO
#undef PW
#undef MOD
#undef HC
#undef CXBC
#undef CXT
#undef CBT
#undef CDT
#undef CDTV
#undef CACS
#undef HX
#undef V
#undef SZS
#undef GATES
#undef XBC
#undef DTR
#undef DTV
#undef ACS
#undef XT
#undef CG
#undef BT
#undef GT
#undef YF
#undef YP
#undef YB
#undef MRG
extern "C" void kernel_launch(void* const* d_in, const int* in_sizes, int n_in, void* d_out, int out_size, void* d_ws, size_t ws_size, hipStream_t stream) {
    static int grid = 0;
    if (grid == 0) {
        int dev = 0, cus = 0, per_cu = 0;
        (void)hipGetDevice(&dev); (void)hipDeviceGetAttribute(&cus, hipDeviceAttributeMultiprocessorCount, dev);
        (void)hipFuncSetAttribute((const void*)fwd_megakernel, hipFuncAttributeMaxDynamicSharedMemorySize, LDS_BYTES);
        (void)hipOccupancyMaxActiveBlocksPerMultiprocessor(&per_cu, (const void*)fwd_megakernel, NTHR, LDS_BYTES);
        if (per_cu < 1) per_cu = 1;
        grid = cus * per_cu;
        if (n_in != 21 || ws_size < WS_END) { fprintf(stderr, "kernel_launch: unexpected n_in %d / ws %zu\n", n_in, ws_size); }
        (void)hipGetLastError();
    }
    Args a{};
    for (int i = 0; i < 21; ++i) a.in[i] = (const float*)d_in[i];
    a.out = (float*)d_out; a.ws = (unsigned char*)d_ws; a.ph_lo = 0; a.ph_hi = 1 << 20;
    void* kargs[] = {&a};
    hipError_t e = hipLaunchCooperativeKernel((const void*)fwd_megakernel, dim3(grid), dim3(NTHR), kargs, LDS_BYTES, stream);
    if (e != hipSuccess) fprintf(stderr, "cooperative launch failed: %s (grid %d)\n", hipGetErrorString(e), grid);
}
```

```cpp
#include <hip/hip_runtime.h>
#include <hip/hip_cooperative_groups.h>
#include <cstdio>
#include <cstdint>
namespace cg = cooperative_groups;
namespace pg8 {
#define PG8_LAS __attribute__((address_space(3)))
typedef unsigned short bf16_t;
typedef short bf16x8 __attribute__((ext_vector_type(8)));
typedef float f32x4 __attribute__((ext_vector_type(4)));
typedef unsigned u32x4 __attribute__((ext_vector_type(4)));
constexpr int BM = 256, BK = 64, HALF = 128, HTB = HALF * BK * 2  , STAGE_BYTES = 8 * HTB, NXCD = 8, WGM = 8;

__host__ __device__ __forceinline__ int lds_byte(int r, int c) { const int st = (r >> 4) * 2 + (c >> 5), rr = r & 15, cc = c & 31, ob = rr * 64 + cc * 2; return st * 1024 + (ob ^ (((ob >> 9) & 1) << 5)); }
__host__ __device__ __forceinline__ void stage_rc(int b, int& R, int& C) { const int st = b / 1024, sb = b % 1024, swz = sb ^ (((sb >> 9) & 1) << 5); R = (st >> 1) * 16 + swz / 64; C = (st & 1) * 32 + (swz % 64) / 2; }
__host__ __device__ __forceinline__ int perm32(int rho) { const int n = rho >> 4, i = rho & 15; return 8 * (i >> 2) + 4 * n + (i & 3); }

struct Unit { int pm, pn; };
struct Gemm { const bf16_t* A; const bf16_t* Bt; int lda, ldb, K, a_pn_off; };
struct StaticOrder {
    int nM, nN, nwg, G, c;
    __host__ __device__ void init(int M, int N, int G_, int c_) { nM = M / BM; nN = N / BM; nwg = nM * nN; G = G_; c = c_; }
    __host__ __device__ bool next(int i, Unit& u) const {
        const long L = (long)i * G + c; if (L >= nwg) return false;
        int wgid = (int)L; { const int q = nwg / NXCD, r = nwg % NXCD, xcd = wgid % NXCD, off = wgid / NXCD; wgid = (xcd < r ? xcd * (q + 1) : r * (q + 1) + (xcd - r) * q) + off; }
        const int nig = WGM * nN, gid = wgid / nig, fm = gid * WGM, gsz = (nM - fm) < WGM ? (nM - fm) : WGM;
        u.pm = fm + ((wgid % nig) % gsz); u.pn = (wgid % nig) / gsz; return true;
    }
    __device__ __forceinline__ void a_ready(const Unit&) const {}
    __device__ __forceinline__ void done(const Unit&) const {}
};
__device__ __forceinline__ unsigned cvt_pk_bf16(float lo, float hi) { unsigned r; asm volatile("v_cvt_pk_bf16_f32 %0, %1, %2" : "=v"(r) : "v"(lo), "v"(hi)); return r; }
template <class Epi, class Sched, bool ALIGN_EPI = false, bool SP2 = false>
__device__ __forceinline__ void gemm_phase(PG8_LAS unsigned char* lds, const Gemm g, const Sched& S, const Epi& E, int tid_in) {
    int tid_l = tid_in; asm volatile("" : "+v"(tid_l));
    const int tid = tid_l, wid = __builtin_amdgcn_readfirstlane(tid >> 6), lane = tid & 63, wr = wid >> 2, wc = wid & 3, fr = lane & 15, fq = lane >> 4;
    const int K = g.K, nt = K / BK;
    unsigned voffA[2], voffB[2];
#pragma unroll
    for (int i = 0; i < 2; ++i) { int R, C; stage_rc(tid * 16 + i * 8192, R, C); const int Rb = Epi::PERM ? ((R & ~31) + perm32(R & 31)) : R;
        voffA[i] = (unsigned)(R * g.lda + C) * 2u; voffB[i] = (unsigned)(Rb * g.ldb + C) * 2u; }
    const size_t kstep = (size_t)(BK * 2);
    const size_t hstepA = (size_t)HALF * g.lda * 2, hstepB = (size_t)HALF * g.ldb * 2;
    const size_t tstepA = 2 * hstepA, tstepB = 2 * hstepB, pnoffA = (size_t)g.a_pn_off * 2;
    const unsigned ldsw = (unsigned)wid * 1024u;
    const int aoff = lds_byte(wr * 64 + fr, fq * 8), boff = lds_byte(wc * 32 + fr, fq * 8);
#define PG8_SA(b, h) (((b) * 2 + (h)) * HTB)
#define PG8_SB(b, h) ((4 + (b) * 2 + (h)) * HTB)
#define PG8_STAGE(bufoff, gbase, voff) do { _Pragma("unroll") for (int _i = 0; _i < 2; ++_i) \
        __builtin_amdgcn_global_load_lds((const unsigned*)((const char*)(gbase) + (voff)[_i]), (PG8_LAS unsigned*)(lds + (bufoff) + ldsw + _i * 8192), 16, 0, 0); } while (0)
#define PG8_LDA(dst, b, h) do { _Pragma("unroll") for (int m = 0; m < 4; ++m) _Pragma("unroll") for (int k = 0; k < 2; ++k) dst[m][k] = *(const PG8_LAS bf16x8*)(lds + PG8_SA(b, h) + aoff + m * 2048 + k * 1024); } while (0)
#define PG8_LDB(dst, b, h) do { _Pragma("unroll") for (int n = 0; n < 2; ++n) _Pragma("unroll") for (int k = 0; k < 2; ++k) dst[n][k] = *(const PG8_LAS bf16x8*)(lds + PG8_SB(b, h) + boff + n * 2048 + k * 1024); } while (0)
#define PG8_MMA(ai, bj, At, Bt) do { __builtin_amdgcn_s_setprio(1); _Pragma("unroll") for (int m = 0; m < 4; ++m) _Pragma("unroll") for (int n = 0; n < 2; ++n) _Pragma("unroll") for (int k = 0; k < 2; ++k) \
        acc[ai][bj][m][n] = __builtin_amdgcn_mfma_f32_16x16x32_bf16(Bt[n][k], At[m][k], acc[ai][bj][m][n], 0, 0, 0); __builtin_amdgcn_s_setprio(0); } while (0)
#define PG8_WAIT_V(n) asm volatile("s_waitcnt vmcnt(" #n ")" ::: "memory")
#define PG8_WAIT_L(n) asm volatile("s_waitcnt lgkmcnt(" #n ")" ::: "memory")
#define PG8_BAR __builtin_amdgcn_s_barrier()
#define PG8_SCHED __builtin_amdgcn_sched_barrier(0)
    Unit cur, nxt; int ui = 0;
    if (!S.next(0, cur)) return;
    f32x4 acc[2][2][4][2];
#pragma unroll
    for (int a = 0; a < 2; ++a)
#pragma unroll
        for (int b = 0; b < 2; ++b)
#pragma unroll
            for (int m = 0; m < 4; ++m)
#pragma unroll
                for (int n = 0; n < 2; ++n) acc[a][b][m][n] = (f32x4){0.f, 0.f, 0.f, 0.f};
    bf16x8 At[4][2], B0[2][2], B1[2][2];
    const char* cA = (const char*)g.A + (size_t)cur.pm * tstepA + (size_t)cur.pn * pnoffA; const char* cB = (const char*)g.Bt + (size_t)cur.pn * tstepB;
    S.a_ready(cur);
    if constexpr (SP2) {
        PG8_STAGE(PG8_SB(0, 0), cB, voffB); PG8_STAGE(PG8_SB(0, 1), cB + hstepB, voffB); PG8_STAGE(PG8_SA(0, 0), cA, voffA); PG8_STAGE(PG8_SA(0, 1), cA + hstepA, voffA);
        if (wr == 1) PG8_BAR;
        PG8_WAIT_V(2); PG8_BAR;
        PG8_STAGE(PG8_SB(1, 0), cB + kstep, voffB); PG8_STAGE(PG8_SA(1, 0), cA + kstep, voffA); PG8_STAGE(PG8_SB(1, 1), cB + hstepB + kstep, voffB);
        PG8_WAIT_V(6); PG8_BAR;
    } else {
        PG8_STAGE(PG8_SB(0, 0), cB, voffB); PG8_STAGE(PG8_SA(0, 0), cA, voffA); PG8_STAGE(PG8_SB(0, 1), cB + hstepB, voffB); PG8_STAGE(PG8_SA(0, 1), cA + hstepA, voffA);
        if (wr == 1) PG8_BAR;
        PG8_WAIT_V(4); PG8_BAR;
        PG8_STAGE(PG8_SB(1, 0), cB + kstep, voffB); PG8_STAGE(PG8_SA(1, 0), cA + kstep, voffA); PG8_STAGE(PG8_SB(1, 1), cB + hstepB + kstep, voffB);
        PG8_WAIT_V(6); PG8_BAR;
    }
    for (;;) {
        const bool has_next = S.next(ui + 1, nxt);
        const char* nA = has_next ? (const char*)g.A + (size_t)nxt.pm * tstepA + (size_t)nxt.pn * pnoffA : cA; const char* nB = has_next ? (const char*)g.Bt + (size_t)nxt.pn * tstepB : cB;
        for (int t = 0; t < nt; t += 2) {
            const bool last = (t == nt - 2);
            const char* a1 = cA + (size_t)(t + 1) * kstep;
            const char* a2 = last ? nA : cA + (size_t)(t + 2) * kstep; const char* b2 = last ? nB : cB + (size_t)(t + 2) * kstep;
            const char* a3 = a2 + kstep; const char* b3 = b2 + kstep;
            if (last && has_next) S.a_ready(nxt);
            if constexpr (SP2) {
            PG8_LDB(B0, 0, 0); PG8_LDB(B1, 0, 1); PG8_SCHED; PG8_LDA(At, 0, 0); PG8_STAGE(PG8_SA(1, 1), a1 + hstepA, voffA);
            PG8_WAIT_V(8); PG8_WAIT_L(0); PG8_BAR; PG8_MMA(0, 0, At, B0); PG8_MMA(0, 1, At, B1); PG8_BAR; PG8_SCHED;
            PG8_LDA(At, 0, 1); PG8_STAGE(PG8_SB(0, 0), b2, voffB); PG8_STAGE(PG8_SB(0, 1), b2 + hstepB, voffB); PG8_STAGE(PG8_SA(0, 0), a2, voffA);
            PG8_WAIT_V(8); PG8_WAIT_L(0); PG8_BAR; PG8_MMA(1, 0, At, B0); PG8_MMA(1, 1, At, B1); PG8_BAR; PG8_SCHED;
            PG8_LDB(B0, 1, 0); PG8_LDB(B1, 1, 1); PG8_SCHED; PG8_LDA(At, 1, 0); PG8_STAGE(PG8_SA(0, 1), a2 + hstepA, voffA);
            PG8_WAIT_V(8); PG8_WAIT_L(0); PG8_BAR; PG8_MMA(0, 0, At, B0); PG8_MMA(0, 1, At, B1); PG8_BAR; PG8_SCHED;
            PG8_LDA(At, 1, 1); PG8_STAGE(PG8_SB(1, 0), b3, voffB); PG8_STAGE(PG8_SB(1, 1), b3 + hstepB, voffB); PG8_STAGE(PG8_SA(1, 0), a3, voffA);
            PG8_WAIT_V(8); PG8_WAIT_L(0); PG8_BAR; PG8_MMA(1, 0, At, B0); PG8_MMA(1, 1, At, B1); PG8_BAR; PG8_SCHED;
            } else {
            PG8_LDB(B0, 0, 0); PG8_SCHED; PG8_LDA(At, 0, 0); PG8_STAGE(PG8_SA(1, 1), a1 + hstepA, voffA);
            PG8_WAIT_L(8); PG8_BAR; PG8_WAIT_L(0); PG8_MMA(0, 0, At, B0); PG8_BAR; PG8_SCHED;
            PG8_LDB(B1, 0, 1); PG8_STAGE(PG8_SB(0, 0), b2, voffB);
            PG8_BAR; PG8_WAIT_L(0); PG8_MMA(0, 1, At, B1); PG8_BAR;
            PG8_LDA(At, 0, 1); PG8_STAGE(PG8_SA(0, 0), a2, voffA);
            PG8_BAR; PG8_WAIT_L(0); PG8_MMA(1, 0, At, B0); PG8_BAR; PG8_SCHED;
            PG8_STAGE(PG8_SB(0, 1), b2 + hstepB, voffB);
            PG8_WAIT_V(6); PG8_BAR; PG8_MMA(1, 1, At, B1); PG8_BAR;
            PG8_LDB(B0, 1, 0); PG8_SCHED; PG8_LDA(At, 1, 0); PG8_STAGE(PG8_SA(0, 1), a2 + hstepA, voffA);
            PG8_WAIT_L(8); PG8_BAR; PG8_WAIT_L(0); PG8_MMA(0, 0, At, B0); PG8_BAR; PG8_SCHED;
            PG8_LDB(B1, 1, 1); PG8_STAGE(PG8_SB(1, 0), b3, voffB);
            PG8_BAR; PG8_WAIT_L(0); PG8_MMA(0, 1, At, B1); PG8_BAR;
            PG8_LDA(At, 1, 1); PG8_STAGE(PG8_SA(1, 0), a3, voffA);
            PG8_BAR; PG8_WAIT_L(0); PG8_MMA(1, 0, At, B0); PG8_BAR; PG8_SCHED;
            PG8_STAGE(PG8_SB(1, 1), b3 + hstepB, voffB);
            PG8_WAIT_V(6); PG8_BAR; PG8_MMA(1, 1, At, B1); PG8_BAR;
            }
        }
        if constexpr (ALIGN_EPI) { if (wr == 0) PG8_BAR; }
        if constexpr (!Epi::AFTER_DRAIN) { E(acc, cur, wr, wc, fr, fq); S.done(cur); }
        if (!has_next) break;
#pragma unroll
        for (int a = 0; a < 2; ++a)
#pragma unroll
            for (int b = 0; b < 2; ++b)
#pragma unroll
                for (int m = 0; m < 4; ++m)
#pragma unroll
                    for (int n = 0; n < 2; ++n) acc[a][b][m][n] = (f32x4){0.f, 0.f, 0.f, 0.f};
        cur = nxt; cA = nA; cB = nB; ++ui;
        if constexpr (ALIGN_EPI) { if (wr == 1) PG8_BAR; }
    }
    PG8_WAIT_V(0);
    if constexpr (!ALIGN_EPI) { if (wr == 0) PG8_BAR; }
    PG8_BAR;
    if constexpr (Epi::AFTER_DRAIN) { E.fused(acc, cur, wr, wc, fr, fq, lds, wid, lane); S.done(cur); }
#undef PG8_SA
#undef PG8_SB
#undef PG8_STAGE
#undef PG8_LDA
#undef PG8_LDB
#undef PG8_MMA
#undef PG8_WAIT_V
#undef PG8_WAIT_L
#undef PG8_BAR
#undef PG8_SCHED
}
}
using pg8::bf16_t; using pg8::bf16x8; using pg8::f32x4; using pg8::u32x4; using pg8::cvt_pk_bf16;
#define LAS __attribute__((address_space(3)))
typedef unsigned u32x2 __attribute__((ext_vector_type(2)));
#define DI __device__ __forceinline__

constexpr int D = 1024, BATCH = 16, SEQ = 4096, CTXL = 256, NH = 32;
constexpr int INP = 9472;
constexpr int NB = 8, T = NB * SEQ, NGRP = BATCH / NB, CT = BATCH * CTXL;
constexpr float EPS = 1e-6f;
constexpr int NTHR = 512;
constexpr int LDS_BYTES = 147456;

constexpr size_t MiB = 1u << 20;
constexpr size_t al256(size_t x) { return (x + 255) & ~(size_t)255; }
constexpr size_t WS_WIN = 0;
constexpr size_t WS_WPP = WS_WIN + al256((size_t)INP * 1024 * 2);
constexpr size_t WS_WPS = WS_WPP + 2 * MiB;
constexpr size_t WS_WO = WS_WPS + 4 * MiB;
constexpr size_t WS_PW = WS_WO + 2 * MiB;
constexpr size_t WS_MOD = WS_PW + MiB / 2;
constexpr size_t WS_HC = WS_MOD + al256(17 * 3072 * 4);
constexpr size_t WS_CXBC = WS_HC + (size_t)CT * 1024 * 2;
constexpr size_t WS_CDT = WS_CXBC + (size_t)CT * 3072 * 2;
constexpr size_t WS_CXT = WS_CDT + (size_t)CT * 64 * 4;
constexpr size_t WS_CBT = WS_CXT + (size_t)CT * 2048 * 2;
constexpr size_t WS_CDTV = WS_CBT + (size_t)CT * 512 * 2;
constexpr size_t WS_CACS = WS_CDTV + (size_t)2 * CT * 32 * 4;
constexpr size_t WS_HX = WS_CACS + (size_t)2 * CT * 32 * 4;
constexpr size_t WS_V = WS_HX + (size_t)T * 1024 * 2;
constexpr size_t WS_SZS = WS_V + (size_t)T * 1024 * 2;
constexpr size_t WS_GATES = WS_SZS + (size_t)T * 2048 * 2;
constexpr size_t WS_XBC = WS_GATES + (size_t)T * 2048 * 2;
constexpr size_t WS_DTR = WS_XBC + (size_t)T * 3072 * 2;
constexpr size_t WS_XT = WS_DTR + (size_t)T * 64 * 4;
constexpr size_t WS_CG = WS_XT + (size_t)T * 2048 * 2;
constexpr size_t WS_BT = WS_CG + (size_t)T * 512 * 2;
constexpr size_t WS_GT = WS_BT + (size_t)T * 512 * 2;
constexpr size_t WS_DTV = WS_GT + (size_t)T * 512 * 2;
constexpr size_t WS_ACS = WS_DTV + (size_t)2 * T * 32 * 4;
constexpr size_t WS_END = WS_ACS + (size_t)2 * T * 32 * 4;
constexpr size_t WS_YF = WS_XBC, WS_YP = WS_XBC + (size_t)T * 2048 * 2, WS_YB = WS_HX, WS_MRG = WS_HX;
static_assert(WS_END <= 1024 * MiB, "workspace map");

DI float bflo(unsigned w) { return __uint_as_float(w << 16); }
DI float bfhi(unsigned w) { return __uint_as_float(w & 0xffff0000u); }
DI float silu_f(float x) { return x * __builtin_amdgcn_rcpf(1.f + __expf(-x)); }
DI float sigm_f(float x) { return __builtin_amdgcn_rcpf(1.f + __expf(-x)); }
DI float wave_sum(float v, int lane) {
#pragma unroll
    for (int o = 1; o < 64; o <<= 1) v += __int_as_float(__builtin_amdgcn_ds_bpermute((lane ^ o) << 2, __float_as_int(v)));
    return v;
}
DI u32x4 pack8(const float* o) { u32x4 w; w.x = cvt_pk_bf16(o[0], o[1]); w.y = cvt_pk_bf16(o[2], o[3]); w.z = cvt_pk_bf16(o[4], o[5]); w.w = cvt_pk_bf16(o[6], o[7]); return w; }
DI void unpack8(u32x4 w, float* o) { o[0] = bflo(w.x); o[1] = bfhi(w.x); o[2] = bflo(w.y); o[3] = bfhi(w.y); o[4] = bflo(w.z); o[5] = bfhi(w.z); o[6] = bflo(w.w); o[7] = bfhi(w.w); }
#define MFMA16(a, b, c) __builtin_amdgcn_mfma_f32_16x16x32_bf16((a), (b), (c), 0, 0, 0)

DI int fresh_lane() { unsigned m = ~0u; asm volatile("" : "+s"(m)); int l = (int)__builtin_amdgcn_mbcnt_hi(m, __builtin_amdgcn_mbcnt_lo(m, 0u)); asm volatile("" : "+v"(l)); return l; }
struct EpiInProj {
    static constexpr bool PERM = true, AFTER_DRAIN = false;
    bf16_t *V, *SZP, *SZS, *GATES, *XBC; float* DT; const float* b_merge; int pn_base;
    __device__ __forceinline__ void operator()(const f32x4 (&acc)[2][2][4][2], const pg8::Unit& u, int wr, int wc, int, int) const { const int ln_ = fresh_lane(), fr = ln_ & 15, fq = ln_ >> 4;
        const int pn = u.pn + pn_base; int mode, ldc, colt; bf16_t* O;
        if (pn < 4) { mode = 0; O = V; ldc = 1024; colt = pn * 256; }
        else if (pn < 8) { mode = 1; O = SZP; ldc = 1024; colt = (pn - 4) * 256; }
        else if (pn < 16) { mode = 1; O = SZS; ldc = 2048; colt = (pn - 8) * 256; }
        else if (pn < 24) { mode = 2; O = GATES; ldc = 2048; colt = (pn - 16) * 256; }
        else if (pn < 36) { mode = 0; O = XBC; ldc = 3072; colt = (pn - 24) * 256; }
        else { mode = 3; O = nullptr; ldc = 64; colt = 0; }
        const int row0 = u.pm * 256 + wr * 64 + fr;
        if (mode == 3) {
            if (wc < 2) {
#pragma unroll
                for (int ai = 0; ai < 2; ++ai)
#pragma unroll
                    for (int m = 0; m < 4; ++m) { float* rp = DT + (size_t)(row0 + ai * 128 + m * 16) * 64 + wc * 32 + 8 * fq;
                        *(f32x4*)rp = acc[ai][0][m][0]; *(f32x4*)(rp + 4) = acc[ai][0][m][1]; }
            }
            return;
        }
        const int col0 = colt + wc * 32 + 8 * fq;
#define INPROJ_WALK(...) \
        _Pragma("unroll") for (int ai = 0; ai < 2; ++ai) _Pragma("unroll") for (int m = 0; m < 4; ++m) { bf16_t* rowp = O + (size_t)(row0 + ai * 128 + m * 16) * ldc + col0; \
            _Pragma("unroll") for (int bj = 0; bj < 2; ++bj) { f32x4 v0 = acc[ai][bj][m][0], v1 = acc[ai][bj][m][1]; __VA_ARGS__ \
                u32x4 w; w.x = cvt_pk_bf16(v0[0], v0[1]); w.y = cvt_pk_bf16(v0[2], v0[3]); w.z = cvt_pk_bf16(v1[0], v1[1]); w.w = cvt_pk_bf16(v1[2], v1[3]); \
                *(u32x4*)(rowp + bj * 128) = w; } asm volatile("" ::: "memory"); }
        if (mode == 0) { INPROJ_WALK() }
        else if (mode == 1) { INPROJ_WALK(_Pragma("unroll") for (int e = 0; e < 4; ++e) { v0[e] = silu_f(v0[e]); v1[e] = silu_f(v1[e]); }) }
        else { INPROJ_WALK({ const f32x4 b0 = *(const f32x4*)(b_merge + col0 + bj * 128), b1 = *(const f32x4*)(b_merge + col0 + bj * 128 + 4);
                 _Pragma("unroll") for (int e = 0; e < 4; ++e) { v0[e] = sigm_f(v0[e] + b0[e]); v1[e] = sigm_f(v1[e] + b1[e]); } }) }
#undef INPROJ_WALK
    }
};
#define EPI_WALK(...) \
    const int row0_ = u.pm * 256 + wr * 64 + fr, col0_ = u.pn * 256 + wc * 32 + 8 * fq; \
    _Pragma("unroll") for (int ai = 0; ai < 2; ++ai) _Pragma("unroll") for (int m = 0; m < 4; ++m) { const size_t row = (size_t)(row0_ + ai * 128 + m * 16); \
    _Pragma("unroll") for (int bj = 0; bj < 2; ++bj) { const int col = col0_ + bj * 128; const f32x4 v0 = acc[ai][bj][m][0], v1 = acc[ai][bj][m][1]; __VA_ARGS__ } asm volatile("" ::: "memory"); }

struct EpiPool {
    static constexpr bool PERM = true, AFTER_DRAIN = false;
    bf16_t* YP; const bf16_t* SZP; const float* pscale;
    __device__ __forceinline__ void operator()(const f32x4 (&acc)[2][2][4][2], const pg8::Unit& u, int wr, int wc, int, int) const { const int ln_ = fresh_lane(), fr = ln_ & 15, fq = ln_ >> 4;
        EPI_WALK({ const f32x4 s0 = *(const f32x4*)(pscale + col), s1 = *(const f32x4*)(pscale + col + 4); float z[8]; unpack8(*(const u32x4*)(SZP + row * 1024 + col), z);
            float o[8]; o[0] = v0[0] * s0[0] * z[0]; o[1] = v0[1] * s0[1] * z[1]; o[2] = v0[2] * s0[2] * z[2]; o[3] = v0[3] * s0[3] * z[3];
            o[4] = v1[0] * s1[0] * z[4]; o[5] = v1[1] * s1[1] * z[5]; o[6] = v1[2] * s1[2] * z[6]; o[7] = v1[3] * s1[3] * z[7];
            *(u32x4*)(YP + row * 1024 + col) = pack8(o); })
    }
};
struct EpiM1 {
    static constexpr bool PERM = true, AFTER_DRAIN = false;
    float* TMP; const bf16_t* GATES;
    __device__ __forceinline__ void operator()(const f32x4 (&acc)[2][2][4][2], const pg8::Unit& u, int wr, int wc, int, int) const { const int ln_ = fresh_lane(), fr = ln_ & 15, fq = ln_ >> 4;
        EPI_WALK({ float gt[8]; unpack8(*(const u32x4*)(GATES + row * 2048 + col), gt);
            f32x4 o0, o1; o0[0] = v0[0] * gt[0]; o0[1] = v0[1] * gt[1]; o0[2] = v0[2] * gt[2]; o0[3] = v0[3] * gt[3]; o1[0] = v1[0] * gt[4]; o1[1] = v1[1] * gt[5]; o1[2] = v1[2] * gt[6]; o1[3] = v1[3] * gt[7];
            *(f32x4*)(TMP + row * 1024 + col) = o0; *(f32x4*)(TMP + row * 1024 + col + 4) = o1; })
    }
};
struct EpiM2 {
    static constexpr bool PERM = true, AFTER_DRAIN = false;
    const float* TMP; const bf16_t* GATES; bf16_t* MRG;
    __device__ __forceinline__ void operator()(const f32x4 (&acc)[2][2][4][2], const pg8::Unit& u, int wr, int wc, int, int) const { const int ln_ = fresh_lane(), fr = ln_ & 15, fq = ln_ >> 4;
        EPI_WALK({ float gt[8]; unpack8(*(const u32x4*)(GATES + row * 2048 + 1024 + col), gt);
            const f32x4 t0 = *(const f32x4*)(TMP + row * 1024 + col), t1 = *(const f32x4*)(TMP + row * 1024 + col + 4);
            float o[8]; o[0] = t0[0] + v0[0] * gt[0]; o[1] = t0[1] + v0[1] * gt[1]; o[2] = t0[2] + v0[2] * gt[2]; o[3] = t0[3] + v0[3] * gt[3];
            o[4] = t1[0] + v1[0] * gt[4]; o[5] = t1[1] + v1[1] * gt[5]; o[6] = t1[2] + v1[2] * gt[6]; o[7] = t1[3] + v1[3] * gt[7];
            *(u32x4*)(MRG + row * 1024 + col) = pack8(o); })
    }
};
struct EpiF32 {
    static constexpr bool PERM = true, AFTER_DRAIN = false;
    float* O;
    __device__ __forceinline__ void operator()(const f32x4 (&acc)[2][2][4][2], const pg8::Unit& u, int wr, int wc, int, int) const { const int ln_ = fresh_lane(), fr = ln_ & 15, fq = ln_ >> 4;
        EPI_WALK({ *(f32x4*)(O + row * 1024 + col) = v0; *(f32x4*)(O + row * 1024 + col + 4) = v1; })
    }
};
DI void transpose_item(const float* W, int K, int N, bf16_t* WT, int ldo, int row_off, LAS float* scr, int item, int lane) {
    const int nblk = N / 32, kb = item / nblk, nb = item % nblk, k0 = 64 * kb, n0 = 32 * nb;
#pragma unroll 8
    for (int i = 0; i < 32; ++i) { const int kk = 2 * i + (lane >> 5); scr[kk * 33 + (lane & 31)] = W[(size_t)(k0 + kk) * N + n0 + (lane & 31)]; }
    asm volatile("s_waitcnt lgkmcnt(0)" ::: "memory");
    const int c = lane & 7;
#pragma unroll
    for (int j = 0; j < 4; ++j) { const int n = (lane >> 3) + 8 * j; const LAS float* s = scr + (8 * c) * 33 + n;
        u32x4 o; o.x = cvt_pk_bf16(s[0 * 33], s[1 * 33]); o.y = cvt_pk_bf16(s[2 * 33], s[3 * 33]); o.z = cvt_pk_bf16(s[4 * 33], s[5 * 33]); o.w = cvt_pk_bf16(s[6 * 33], s[7 * 33]);
        *(u32x4*)(WT + (size_t)(row_off + n0 + n) * ldo + k0 + 8 * c) = o; }
    asm volatile("s_waitcnt lgkmcnt(0)" ::: "memory");
}
DI void mod_item(LAS unsigned char* lds, const float* c, const float* c_ctx, const float* w_ada, const float* b_ada, float* MOD, int item, int tid) {
    LAS float* sS = (LAS float*)lds;
    LAS float* sP = (LAS float*)(lds + 17 * 1024 * 4);
    for (int i = tid; i < 17 * 1024; i += NTHR) { const float v = i < 16 * 1024 ? c[i] : c_ctx[i - 16 * 1024]; sS[i] = silu_f(v); }
    __syncthreads();
    const int col = tid & 63, kseg = tid >> 6, n = item * 64 + col;
    float acc[17];
#pragma unroll
    for (int r = 0; r < 17; ++r) acc[r] = 0.f;
    for (int k = kseg * 128; k < kseg * 128 + 128; ++k) { const float w = w_ada[(size_t)k * 3072 + n];
#pragma unroll
        for (int r = 0; r < 17; ++r) acc[r] += sS[r * 1024 + k] * w; }
#pragma unroll
    for (int r = 0; r < 17; ++r) sP[(kseg * 17 + r) * 64 + col] = acc[r];
    __syncthreads();
    for (int i = tid; i < 17 * 64; i += NTHR) { const int r = i >> 6, cc = i & 63; float s = b_ada[item * 64 + cc];
#pragma unroll
        for (int q = 0; q < 8; ++q) s += sP[(q * 17 + r) * 64 + cc];
        MOD[r * 3072 + item * 64 + cc] = s; }
    __syncthreads();
}
DI void modnorm_row(const float* xrow, const float* npre, const float* mod, bf16_t* orow, int lane) {
    f32x4 v[4]; float ss = 0.f;
#pragma unroll
    for (int j = 0; j < 4; ++j) { v[j] = *(const f32x4*)(xrow + 4 * lane + 256 * j); ss += (v[j].x * v[j].x + v[j].y * v[j].y) + (v[j].z * v[j].z + v[j].w * v[j].w); }
    const float rstd = rsqrtf(wave_sum(ss, lane) * (1.f / 1024.f) + EPS);
#pragma unroll
    for (int j = 0; j < 4; ++j) { const int c0 = 4 * lane + 256 * j; const f32x4 w = *(const f32x4*)(npre + c0), sh = *(const f32x4*)(mod + c0), sc = *(const f32x4*)(mod + 1024 + c0);
        f32x4 o;
#pragma unroll
        for (int e = 0; e < 4; ++e) o[e] = v[j][e] * rstd * w[e] * (1.f + sc[e]) + sh[e];
        u32x2 p; p.x = cvt_pk_bf16(o[0], o[1]); p.y = cvt_pk_bf16(o[2], o[3]); *(u32x2*)(orow + c0) = p; }
}
DI void final_row(float* yrow, const float* xrow, const float* npost, const float* gate, int lane) {
    f32x4 v[4]; float ss = 0.f;
#pragma unroll
    for (int j = 0; j < 4; ++j) { v[j] = *(const f32x4*)(yrow + 4 * lane + 256 * j); ss += (v[j].x * v[j].x + v[j].y * v[j].y) + (v[j].z * v[j].z + v[j].w * v[j].w); }
    const float rstd = rsqrtf(wave_sum(ss, lane) * (1.f / 1024.f) + EPS);
#pragma unroll
    for (int j = 0; j < 4; ++j) { const int c0 = 4 * lane + 256 * j; const f32x4 w = *(const f32x4*)(npost + c0), g = *(const f32x4*)(gate + c0), x = *(const f32x4*)(xrow + c0);
        f32x4 o;
#pragma unroll
        for (int e = 0; e < 4; ++e) o[e] = x[e] + g[e] * (v[j][e] * rstd * w[e]);
        *(f32x4*)(yrow + c0) = o; }
}
DI void gnorm_item(bf16_t* yf, const bf16_t* yb, const bf16_t* szs, const float* w, int lane) {
    float a[8], b[8], z[8], u[8]; unpack8(*(const u32x4*)(yf + lane * 8), a); unpack8(*(const u32x4*)(yb + lane * 8), b); unpack8(*(const u32x4*)(szs + lane * 8), z);
    float ss = 0.f;
#pragma unroll
    for (int e = 0; e < 8; ++e) { u[e] = (a[e] + b[e]) * z[e]; ss += u[e] * u[e]; }
    const float r = rsqrtf(wave_sum(ss, lane) * (1.f / 512.f) + EPS);
    const f32x4 w0 = *(const f32x4*)(w + lane * 8), w1 = *(const f32x4*)(w + lane * 8 + 4);
    float o[8];
#pragma unroll
    for (int e = 0; e < 4; ++e) { o[e] = u[e] * r * w0[e]; o[4 + e] = u[4 + e] * r * w1[e]; }
    *(u32x4*)(yf + lane * 8) = pack8(o);
}

constexpr int RS = 272;
DI void conv_xs_wave(LAS unsigned char* wl, const bf16_t* src, int L, int c, int hb, bf16_t* dst_tile, const float* conv_w, const float* conv_b, int lane) {
    const int cp = lane & 31, th = lane >> 5, ch = hb * 64 + 2 * cp;
    float w0[4], w1[4];
#pragma unroll
    for (int k = 0; k < 4; ++k) { w0[k] = conv_w[k * 3072 + ch]; w1[k] = conv_w[k * 3072 + ch + 1]; }
    const float b0 = conv_b[ch], b1 = conv_b[ch + 1];
    const int t0 = c * 128 + th * 64 - 2;
    unsigned raw[67];
#pragma unroll
    for (int r = 0; r < 67; ++r) { const int t = t0 + r; raw[r] = 0u; if (t >= 0 && t < L) raw[r] = *(const unsigned*)(src + (size_t)t * 3072 + ch); }
#pragma unroll
    for (int blk = 0; blk < 8; ++blk) { float o0[8], o1[8];
#pragma unroll
        for (int u = 0; u < 8; ++u) { float s0 = b0, s1 = b1;
#pragma unroll
            for (int k = 0; k < 4; ++k) { s0 += w0[k] * bflo(raw[blk * 8 + u + k]); s1 += w1[k] * bfhi(raw[blk * 8 + u + k]); }
            o0[u] = silu_f(s0); o1[u] = silu_f(s1); }
        *(LAS u32x4*)(wl + (2 * cp) * RS + (th * 64 + blk * 8) * 2) = pack8(o0);
        *(LAS u32x4*)(wl + (2 * cp + 1) * RS + (th * 64 + blk * 8) * 2) = pack8(o1); }
    asm volatile("s_waitcnt lgkmcnt(0)" ::: "memory");
#pragma unroll
    for (int q = 0; q < 16; ++q) { const int row = q * 4 + (lane >> 4), cb = (lane & 15) * 16;
        *(u32x4*)((char*)dst_tile + row * 256 + cb) = *(const LAS u32x4*)(wl + row * RS + cb); }
    asm volatile("s_waitcnt lgkmcnt(0)" ::: "memory");
}
DI void conv_bc_item(LAS unsigned char* lds, const bf16_t* src, int L, int c, int g, bf16_t* bt_tile, bf16_t* cg_rows, bf16_t* gt_tile, const float* conv_w, const float* conv_b, int tid) {
    LAS unsigned char* sB = lds; LAS unsigned char* sC = lds + 128 * RS;
    {
        const int p_ = tid & 127, tq = tid >> 7, mat = p_ >> 6, n2 = 2 * (p_ & 63), ch = 2048 + mat * 512 + g * 128 + n2;
        LAS unsigned char* sM = mat ? sC : sB;
        float w0[4], w1[4];
#pragma unroll
        for (int k = 0; k < 4; ++k) { w0[k] = conv_w[k * 3072 + ch]; w1[k] = conv_w[k * 3072 + ch + 1]; }
        const float b0 = conv_b[ch], b1 = conv_b[ch + 1];
        unsigned raw[4][11];
#pragma unroll
        for (int ps = 0; ps < 4; ++ps)
#pragma unroll
            for (int r = 0; r < 11; ++r) { const int t = c * 128 + (ps * 4 + tq) * 8 - 2 + r; raw[ps][r] = 0u; if (t >= 0 && t < L) raw[ps][r] = *(const unsigned*)(src + (size_t)t * 3072 + ch); }
#pragma unroll
        for (int ps = 0; ps < 4; ++ps) { const int tk0 = (ps * 4 + tq) * 8; float o0[8], o1[8];
#pragma unroll
            for (int u = 0; u < 8; ++u) { float s0 = b0, s1 = b1;
#pragma unroll
                for (int k = 0; k < 4; ++k) { s0 += w0[k] * bflo(raw[ps][u + k]); s1 += w1[k] * bfhi(raw[ps][u + k]); }
                o0[u] = silu_f(s0); o1[u] = silu_f(s1);
                *(LAS unsigned*)(sM + (tk0 + u) * RS + n2 * 2) = cvt_pk_bf16(o0[u], o1[u]); }
            if (mat == 0) { *(u32x4*)(bt_tile + (size_t)n2 * 128 + tk0) = pack8(o0); *(u32x4*)(bt_tile + (size_t)(n2 + 1) * 128 + tk0) = pack8(o1); } }
    }
    __syncthreads();
    if (cg_rows) { const int row = tid >> 2, cb = (tid & 3) * 64;
#pragma unroll
        for (int q = 0; q < 4; ++q) *(u32x4*)((char*)(cg_rows + (size_t)row * 512) + cb + q * 16) = *(const LAS u32x4*)(sC + row * RS + cb + q * 16); }
    if (gt_tile) { const int wid = tid >> 6, lane = tid & 63, fr = lane & 15, fq = lane >> 4;
        f32x4 acc[8];
#pragma unroll
        for (int jb = 0; jb < 8; ++jb) acc[jb] = (f32x4){0.f, 0.f, 0.f, 0.f};
#pragma unroll
        for (int ks = 0; ks < 4; ++ks) { const bf16x8 cf = *(const LAS bf16x8*)(sC + (16 * wid + fr) * RS + (ks * 32 + fq * 8) * 2);
#pragma unroll
            for (int jb = 0; jb < 8; ++jb) { const bf16x8 bfr = *(const LAS bf16x8*)(sB + (jb * 16 + fr) * RS + (ks * 32 + fq * 8) * 2); acc[jb] = MFMA16(bfr, cf, acc[jb]); } }
#pragma unroll
        for (int jb = 0; jb < 8; ++jb) { u32x2 p; p.x = cvt_pk_bf16(acc[jb][0], acc[jb][1]); p.y = cvt_pk_bf16(acc[jb][2], acc[jb][3]);
            *(u32x2*)(gt_tile + (size_t)(16 * wid + fr) * 128 + jb * 16 + fq * 4) = p; } }
    __syncthreads();
}
DI void dt_item(LAS unsigned char* lds, const float* dtr, int L, int c, float* dtv, float* acs, size_t dir_stride, const float* dt_bias, const float* a_log, int tid) {
    LAS float* sTot = (LAS float*)lds;
    const int col = tid & 63, seg = tid >> 6, dir = col >> 5, h = col & 31;
    const float bias = dt_bias[col], A = -__expf(a_log[col]);
    float dtl[16], cs[16];
#pragma unroll
    for (int u = 0; u < 16; ++u) { const float x = dtr[(size_t)(c * 128 + seg * 16 + u) * 64 + col] + bias; dtl[u] = x > 20.f ? x : log1pf(expf(x)); }
    float run = 0.f;
    if (dir == 0) {
#pragma unroll
        for (int u = 0; u < 16; ++u) { run += dtl[u] * A; cs[u] = run; }
    } else {
#pragma unroll
        for (int u = 15; u >= 0; --u) { run += dtl[u] * A; cs[u] = run; }
    }
    sTot[seg * 64 + col] = run;
    __syncthreads();
    float off = 0.f;
#pragma unroll
    for (int s = 0; s < 8; ++s) { const float v = sTot[s * 64 + col]; if (dir == 0 ? (s < seg) : (s > seg)) off += v; }
    const size_t o = (size_t)dir * dir_stride + (size_t)h * L + c * 128 + seg * 16;
#pragma unroll
    for (int q = 0; q < 4; ++q) { *(f32x4*)(dtv + o + 4 * q) = (f32x4){dtl[4 * q], dtl[4 * q + 1], dtl[4 * q + 2], dtl[4 * q + 3]};
        *(f32x4*)(acs + o + 4 * q) = (f32x4){cs[4 * q] + off, cs[4 * q + 1] + off, cs[4 * q + 2] + off, cs[4 * q + 3] + off}; }
    __syncthreads();
}
DI void pool_wave(LAS unsigned char* wl, const bf16_t* v, bf16_t* dd, int r, int gi, int cq, int lane) {
    LAS float* sV = (LAS float*)wl;
    const int k = 2 << gi, lo = k >> 1, hi = k - 1 - lo;
    const int c8 = lane & 7, wq = lane >> 3, ch = gi * 256 + cq * 64 + c8 * 8;
    const int r_lo = max(r - lo, 0), r_hi = min(r + hi + 1, 64);
    const float inv_r = 1.f / (float)(r_hi - r_lo);
    float acc[8][8]; u32x4 ctr[8];
#pragma unroll
    for (int q = 0; q < 8; ++q) { ctr[q] = (u32x4){0u, 0u, 0u, 0u};
#pragma unroll
        for (int e = 0; e < 8; ++e) acc[q][e] = 0.f; }
    for (int rr = r_lo; rr < r_hi; ++rr) { u32x4 x[8];
#pragma unroll
        for (int q = 0; q < 8; ++q) x[q] = *(const u32x4*)(v + ((size_t)(rr * 64 + wq * 8 + q) * 1024 + ch));
#pragma unroll
        for (int q = 0; q < 8; ++q) { float f[8]; unpack8(x[q], f);
#pragma unroll
            for (int e = 0; e < 8; ++e) acc[q][e] += f[e];
            if (rr == r) ctr[q] = x[q]; } }
#pragma unroll
    for (int q = 0; q < 8; ++q) { LAS float* p = sV + (wq * 8 + q) * 68 + c8 * 8;
        *(LAS f32x4*)p = (f32x4){acc[q][0] * inv_r, acc[q][1] * inv_r, acc[q][2] * inv_r, acc[q][3] * inv_r};
        *(LAS f32x4*)(p + 4) = (f32x4){acc[q][4] * inv_r, acc[q][5] * inv_r, acc[q][6] * inv_r, acc[q][7] * inv_r}; }
    asm volatile("s_waitcnt lgkmcnt(0)" ::: "memory");
    const int wb = wq * 8;
    f32x4 s0 = (f32x4){0.f, 0.f, 0.f, 0.f}, s1 = s0;
    for (int ww = max(wb - lo, 0); ww < min(wb + hi + 1, 64); ++ww) { const LAS float* p = sV + ww * 68 + c8 * 8; s0 += *(const LAS f32x4*)p; s1 += *(const LAS f32x4*)(p + 4); }
#pragma unroll
    for (int q = 0; q < 8; ++q) { const int w = wb + q, w_lo = max(w - lo, 0), w_hi = min(w + hi + 1, 64);
        const float inv_w = 1.f / (float)(w_hi - w_lo); float cv[8]; unpack8(ctr[q], cv); float o[8];
#pragma unroll
        for (int e = 0; e < 4; ++e) { o[e] = s0[e] * inv_w - cv[e]; o[4 + e] = s1[e] * inv_w - cv[4 + e]; }
        *(u32x4*)(dd + ((size_t)(r * 64 + w) * 1024 + ch)) = pack8(o);
        if (q < 7) { const int wa = w + 1 + hi, ws_ = w - lo;
            if (wa < 64) { const LAS float* p = sV + wa * 68 + c8 * 8; s0 += *(const LAS f32x4*)p; s1 += *(const LAS f32x4*)(p + 4); }
            if (ws_ >= 0) { const LAS float* p = sV + ws_ * 68 + c8 * 8; s0 -= *(const LAS f32x4*)p; s1 -= *(const LAS f32x4*)(p + 4); } } }
    asm volatile("s_waitcnt lgkmcnt(0)" ::: "memory");
}
DI void ssd_phase(LAS unsigned char* lds, const unsigned char* ws, const float* d_skip_p, int b0, int vcu, int G, int tid_in) {
    int tid_l = tid_in; asm volatile("" : "+v"(tid_l));
    const int tid = tid_l, wid = __builtin_amdgcn_readfirstlane(tid >> 6), lane = tid & 63, fr = lane & 15, fq = lane >> 4;
    LAS unsigned char* sXT = lds; LAS unsigned char* sHb = lds + 64 * RS;
    LAS float* sDT = (LAS float*)(lds + 2 * 64 * RS); LAS float* sACS = sDT + 128; LAS float* sW = sDT + 256;
    for (int item = vcu; item < NB * 64; item += G) {
        const int dir = item & 1, hh = (item >> 1) & 7, g = (item >> 4) & 3, bl = item >> 6, h = g * 8 + hh, bg = b0 + bl;
        const float dsk = dir == 0 ? d_skip_p[h] : 0.f;
        const unsigned yoff = (unsigned)(dir == 0 ? WS_YF : WS_YB);
        f32x4 accH[4];
#pragma unroll
        for (int pb = 0; pb < 4; ++pb) accH[pb] = (f32x4){0.f, 0.f, 0.f, 0.f};
        u32x4 xt0 = (u32x4){0u, 0u, 0u, 0u}, xt1 = xt0; bf16x8 bt[4], gt[4], cgf[4]; float r_dt = 0.f, r_acs = 0.f, r_alast = 0.f;
#pragma unroll
        for (int ks = 0; ks < 4; ++ks) { bt[ks] = (bf16x8){0, 0, 0, 0, 0, 0, 0, 0}; gt[ks] = bt[ks]; cgf[ks] = bt[ks]; }
        const unsigned lrow = (unsigned)(wid * 16 + fr);
#define SSD_LOAD_XT_DA(s_) do { const int s__ = (s_); unsigned xo, dof, aof; \
        if (s__ < 2) { const int cc = dir == 0 ? s__ : 1 - s__; xo = (unsigned)WS_CXT + (unsigned)((bg * 2 + cc) * 2048 + h * 64) * 256u; const unsigned o = ((unsigned)((dir * 16 + bg) * 32 + h) * 256u + cc * 128) * 4u; dof = (unsigned)WS_CDTV + o; aof = (unsigned)WS_CACS + o; } \
        else { const int c_ = dir == 0 ? s__ - 2 : 33 - s__; xo = (unsigned)WS_XT + (unsigned)((bl * 32 + c_) * 2048 + h * 64) * 256u; const unsigned o = ((unsigned)((dir * NB + bl) * 32 + h) * 4096u + c_ * 128) * 4u; dof = (unsigned)WS_DTV + o; aof = (unsigned)WS_ACS + o; } \
        xt0 = *(const u32x4*)(ws + (xo + tid * 32)); xt1 = *(const u32x4*)(ws + (xo + tid * 32 + 16)); \
        if (tid < 128) { r_dt = *(const float*)(ws + (dof + tid * 4)); r_acs = *(const float*)(ws + (aof + tid * 4)); } r_alast = *(const float*)(ws + (aof + (dir == 0 ? 127 * 4 : 0))); } while (0)
#define SSD_LOAD_BT(s_) do { const int s__ = (s_); unsigned bo; \
        if (s__ < 2) { const int cc = dir == 0 ? s__ : 1 - s__; bo = (unsigned)WS_CBT + (unsigned)((bg * 2 + cc) * 512 + g * 128) * 256u; } \
        else { const int c_ = dir == 0 ? s__ - 2 : 33 - s__; bo = (unsigned)WS_BT + (unsigned)((bl * 32 + c_) * 512 + g * 128) * 256u; } \
        bo += lrow * 256u + fq * 16; \
        _Pragma("unroll") for (int ks = 0; ks < 4; ++ks) bt[ks] = *(const bf16x8*)(ws + (bo + ks * 64)); } while (0)
#define SSD_LOAD_GT_CG(s_) do { const int c_ = dir == 0 ? (s_) - 2 : 33 - (s_); \
        const unsigned go = (unsigned)WS_GT + (unsigned)(((bl * 32 + c_) * 4 + g) * 128) * 256u + lrow * 256u + fq * 16; \
        const unsigned co = (unsigned)WS_CG + ((unsigned)(bl * 4096 + c_ * 128) + lrow) * 1024u + g * 256 + fq * 16; \
        _Pragma("unroll") for (int ks = 0; ks < 4; ++ks) { gt[ks] = *(const bf16x8*)(ws + (go + ks * 64)); cgf[ks] = *(const bf16x8*)(ws + (co + ks * 64)); } } while (0)
        SSD_LOAD_XT_DA(0); SSD_LOAD_BT(0);
        for (int s = 0; s < 34; ++s) {
            { const int row = tid >> 3, cb = (tid & 7) * 32; *(LAS u32x4*)(sXT + row * RS + cb) = xt0; *(LAS u32x4*)(sXT + row * RS + cb + 16) = xt1; }
#pragma unroll
            for (int pb = 0; pb < 4; ++pb) { u32x2 p; p.x = cvt_pk_bf16(accH[pb][0], accH[pb][1]); p.y = cvt_pk_bf16(accH[pb][2], accH[pb][3]);
                *(LAS u32x2*)(sHb + (pb * 16 + fr) * RS + (wid * 16 + fq * 4) * 2) = p; }
            const float alast = r_alast;
            if (tid < 128) { sDT[tid] = r_dt; sACS[tid] = r_acs; sW[tid] = r_dt * __expf(alast - r_acs); }
            __syncthreads();
            if (s + 1 < 34) SSD_LOAD_XT_DA(s + 1);
            if (s >= 2) {
                const int c_ = dir == 0 ? s - 2 : 33 - s;
                f32x4 accO[4], accD[4];
#pragma unroll
                for (int pb = 0; pb < 4; ++pb) { accO[pb] = (f32x4){0.f, 0.f, 0.f, 0.f}; accD[pb] = accO[pb]; }
                int i_l = wid * 16 + fr; asm volatile("" : "+v"(i_l)); const int i = i_l;
                const float acs_i = sACS[i];
#pragma unroll
                for (int ks = 0; ks < 4; ++ks)
#pragma unroll
                    for (int pb = 0; pb < 4; ++pb) { const bf16x8 a = *(const LAS bf16x8*)(sHb + (pb * 16 + fr) * RS + (ks * 32 + fq * 8) * 2); accO[pb] = MFMA16(a, cgf[ks], accO[pb]); }
#pragma unroll
                for (int ks = 0; ks < 4; ++ks) {
                    const bool need = dir == 0 ? (ks <= (wid >> 1)) : (ks >= (wid >> 1));
                    if (need) {
                        const int j0 = ks * 32 + fq * 8;
                        const f32x4 a0 = *(const LAS f32x4*)(sACS + j0), a1 = *(const LAS f32x4*)(sACS + j0 + 4), d0 = *(const LAS f32x4*)(sDT + j0), d1 = *(const LAS f32x4*)(sDT + j0 + 4);
                        float gv[8]; unpack8(__builtin_bit_cast(u32x4, gt[ks]), gv); float mv[8];
#pragma unroll
                        for (int e = 0; e < 8; ++e) { const int j = j0 + e; const float aj = e < 4 ? a0[e & 3] : a1[e & 3], dj = e < 4 ? d0[e & 3] : d1[e & 3];
                            const bool valid = dir == 0 ? (j <= i) : (j >= i);
                            float val = gv[e] * __expf(acs_i - aj) * dj; if (j == i) val += dsk;
                            mv[e] = valid ? val : 0.f; }
                        const bf16x8 mf = __builtin_bit_cast(bf16x8, pack8(mv));
#pragma unroll
                        for (int pb = 0; pb < 4; ++pb) { const bf16x8 a = *(const LAS bf16x8*)(sXT + (pb * 16 + fr) * RS + j0 * 2); accD[pb] = MFMA16(a, mf, accD[pb]); }
                    }
                }
                const float ei = __expf(acs_i);
                unsigned char* yrow = (unsigned char*)ws + (yoff + ((unsigned)(bl * 4096 + c_ * 128 + i) * 2048u + h * 64 + fq * 4) * 2u);
#pragma unroll
                for (int pb = 0; pb < 4; ++pb) { u32x2 p; p.x = cvt_pk_bf16(accD[pb][0] + ei * accO[pb][0], accD[pb][1] + ei * accO[pb][1]); p.y = cvt_pk_bf16(accD[pb][2] + ei * accO[pb][2], accD[pb][3] + ei * accO[pb][3]);
                    *(u32x2*)(yrow + pb * 32) = p; }
            }
            if (s + 1 < 34 && s + 1 >= 2) SSD_LOAD_GT_CG(s + 1);
            { const float dec = __expf(alast);
#pragma unroll
              for (int pb = 0; pb < 4; ++pb) accH[pb] *= dec;
#pragma unroll
              for (int ks = 0; ks < 4; ++ks) { const int j0 = ks * 32 + fq * 8;
                  const f32x4 w0 = *(const LAS f32x4*)(sW + j0), w1 = *(const LAS f32x4*)(sW + j0 + 4);
                  float bv[8]; unpack8(__builtin_bit_cast(u32x4, bt[ks]), bv);
#pragma unroll
                  for (int e = 0; e < 4; ++e) { bv[e] *= w0[e]; bv[4 + e] *= w1[e]; }
                  const bf16x8 bw = __builtin_bit_cast(bf16x8, pack8(bv));
#pragma unroll
                  for (int pb = 0; pb < 4; ++pb) { const bf16x8 xf = *(const LAS bf16x8*)(sXT + (pb * 16 + fr) * RS + j0 * 2); accH[pb] = MFMA16(bw, xf, accH[pb]); } } }
            if (s + 1 < 34) SSD_LOAD_BT(s + 1);
            __syncthreads();
        }
#undef SSD_LOAD_XT_DA
#undef SSD_LOAD_BT
#undef SSD_LOAD_GT_CG
    }
}

struct Args { const float* in[21]; float* out; unsigned char* ws; int ph_lo, ph_hi; };
static_assert(sizeof(Args) == 23 * 8 + 8, "Args has no padding");


#define IN_(k) (args.in[k])
#define x_in IN_(0)
#define c_in IN_(1)
#define ctx IN_(2)
#define c_ctx IN_(3)
#define w_ada IN_(4)
#define b_ada IN_(5)
#define norm_pre IN_(6)
#define norm_post IN_(7)
#define w_in IN_(8)
#define b_merge IN_(9)
#define pool_w IN_(10)
#define pool_scale IN_(11)
#define conv_w IN_(12)
#define conv_b IN_(13)
#define dt_bias IN_(14)
#define a_log IN_(15)
#define d_skip IN_(16)
#define ssd_norm IN_(17)
#define w_proj_pool IN_(18)
#define w_proj_ssd IN_(19)
#define w_out IN_(20)
#define out_p (args.out)
#define WSB(off) ((bf16_t*)(ws_l + (off)))
#define WSF(off) ((float*)(ws_l + (off)))
#define WIN WSB(WS_WIN)
#define WPP WSB(WS_WPP)
#define WPS WSB(WS_WPS)
#define WO WSB(WS_WO)
#define PW WSB(WS_PW)
#define MOD WSF(WS_MOD)
#define HC WSB(WS_HC)
#define CXBC WSB(WS_CXBC)
#define CXT WSB(WS_CXT)
#define CBT WSB(WS_CBT)
#define CDT WSF(WS_CDT)
#define CDTV WSF(WS_CDTV)
#define CACS WSF(WS_CACS)
#define HX WSB(WS_HX)
#define V WSB(WS_V)
#define SZS WSB(WS_SZS)
#define GATES WSB(WS_GATES)
#define XBC WSB(WS_XBC)
#define DTR WSF(WS_DTR)
#define DTV WSF(WS_DTV)
#define ACS WSF(WS_ACS)
#define XT WSB(WS_XT)
#define CG WSB(WS_CG)
#define BT WSB(WS_BT)
#define GT WSB(WS_GT)
#define YF WSB(WS_YF)
#define YP WSB(WS_YP)
#define YB WSB(WS_YB)
#define MRG WSB(WS_MRG)
__global__ void __launch_bounds__(NTHR, 2) fwd_megakernel(Args args) {
    extern __shared__ __attribute__((aligned(16))) unsigned char lds_raw[];
    cg::grid_group grid = cg::this_grid();
    LAS unsigned char* lds = (LAS unsigned char*)lds_raw;
    const int G = gridDim.x, bx = blockIdx.x, NGW = G * 8, wave_k = __builtin_amdgcn_readfirstlane((int)threadIdx.x >> 6);
    const int lo = args.ph_lo, hi = args.ph_hi;
    int ph = 0;
#ifndef PROBE_MASK
#define PROBE_MASK 0
#endif
#define PHASE_BEGIN(id_) if (lo <= ph && ph < hi) { for (int rep_ = 0; rep_ <= ((PROBE_MASK >> (id_)) & 1); ++rep_) { int tid_l = wave_k * 64 + fresh_lane(); asm volatile("" : "+v"(tid_l)); const int tid = tid_l, lane = tid & 63, wave = wave_k; \
        int vcu_l = (G % 8 == 0) ? (bx % 8) * (G / 8) + bx / 8 : bx; asm volatile("" : "+s"(vcu_l)); const int vcu = vcu_l, gw = vcu * 8 + wave; (void)tid; (void)lane; (void)gw; \
        unsigned char* ws_l = args.ws; asm volatile("" : "+s"(ws_l));
#define PHASE_END } } ++ph; if (lo < ph && ph < hi) grid.sync();

    PHASE_BEGIN(0)
        for (int it = vcu; it < 48; it += G) mod_item(lds, c_in, c_ctx, w_ada, b_ada, MOD, it, tid);
        LAS float* scr = (LAS float*)(lds + wave * 16384);
        constexpr int I_IN = 16 * 290, I_PP = 16 * 32, I_PS = 32 * 32, I_O = 16 * 32, I_PW = 4 * 8;
        for (int it = gw; it < I_IN + I_PP + I_PS + I_O + 4 * I_PW; it += NGW) {
            int r = it;
            if (r < I_IN) { transpose_item(w_in, 1024, 9280, WIN, 1024, 0, scr, r, lane); continue; } r -= I_IN;
            if (r < I_PP) { transpose_item(w_proj_pool, 1024, 1024, WPP, 1024, 0, scr, r, lane); continue; } r -= I_PP;
            if (r < I_PS) { transpose_item(w_proj_ssd, 2048, 1024, WPS, 2048, 0, scr, r, lane); continue; } r -= I_PS;
            if (r < I_O) { transpose_item(w_out, 1024, 1024, WO, 1024, 0, scr, r, lane); continue; } r -= I_O;
            { const int gq = r / I_PW; transpose_item(pool_w + (size_t)gq * 65536, 256, 256, PW, 256, gq * 256, scr, r % I_PW, lane); }
        }
    PHASE_END
    PHASE_BEGIN(1)
        for (int m = gw; m < CT; m += NGW) modnorm_row(ctx + (size_t)m * 1024, norm_pre, MOD + 16 * 3072, HC + (size_t)m * 1024, lane);
        for (int m = gw; m < T; m += NGW) modnorm_row(x_in + (size_t)m * 1024, norm_pre, MOD + (m >> 12) * 3072, HX + (size_t)m * 1024, lane);
    PHASE_END
    for (int grp = 0; grp < NGRP; ++grp) {
        const int b0 = grp * NB; const size_t tok0 = (size_t)b0 * SEQ;
        float* outg = out_p + tok0 * 1024;
        bf16_t* SZP = (bf16_t*)outg; bf16_t* DD = (bf16_t*)outg + (size_t)T * 1024;
        PHASE_BEGIN(2)
            if (grp == 0) {
                pg8::Gemm g{HC, WIN + (size_t)24 * 256 * 1024, 1024, 1024, 1024, 0}; pg8::StaticOrder S; S.init(CT, 13 * 256, G, bx);
                EpiInProj E{nullptr, nullptr, nullptr, nullptr, CXBC, CDT, b_merge, 24};
                pg8::gemm_phase<EpiInProj, pg8::StaticOrder, true, true>(lds, g, S, E, tid);
            }
            { pg8::Gemm g{HX, WIN, 1024, 1024, 1024, 0}; pg8::StaticOrder S; S.init(T, INP, G, bx);
              EpiInProj E{V, SZP, SZS, GATES, XBC, DTR, b_merge, 0};
              pg8::gemm_phase<EpiInProj, pg8::StaticOrder, true, true>(lds, g, S, E, tid); }
        PHASE_END
        PHASE_BEGIN(3)
            if (grp == 0) {
                for (int it = vcu; it < 16 * 2 * 4; it += G) { const int g = it & 3, cc = (it >> 2) & 1, b = it >> 3;
                    conv_bc_item(lds, CXBC + (size_t)b * CTXL * 3072, CTXL, cc, g, CBT + ((size_t)((b * 2 + cc) * 512 + g * 128)) * 128, nullptr, nullptr, conv_w, conv_b, tid); }
                for (int it = vcu; it < 16 * 2; it += G) { const int cc = it & 1, b = it >> 1;
                    dt_item(lds, CDT + (size_t)b * CTXL * 64, CTXL, cc, CDTV + (size_t)b * 32 * CTXL, CACS + (size_t)b * 32 * CTXL, (size_t)16 * 32 * CTXL, dt_bias, a_log, tid); }
            }
            for (int it = vcu; it < NB * 32 * 4; it += G) { const int g = it & 3, cc = (it >> 2) & 31, b = it >> 7;
                conv_bc_item(lds, XBC + (size_t)b * SEQ * 3072, SEQ, cc, g, BT + ((size_t)((b * 32 + cc) * 512 + g * 128)) * 128, CG + ((size_t)(b * SEQ + cc * 128)) * 512 + g * 128,
                             GT + ((size_t)(((b * 32 + cc) * 4 + g) * 128)) * 128, conv_w, conv_b, tid); }
            for (int it = vcu; it < NB * 32; it += G) { const int cc = it & 31, b = it >> 5;
                dt_item(lds, DTR + (size_t)b * SEQ * 64, SEQ, cc, DTV + (size_t)b * 32 * SEQ, ACS + (size_t)b * 32 * SEQ, (size_t)NB * 32 * SEQ, dt_bias, a_log, tid); }
            { LAS unsigned char* wl = lds + wave * (64 * RS);
              if (grp == 0) for (int it = gw; it < 16 * 2 * 32; it += NGW) { const int hb = it & 31, cc = (it >> 5) & 1, b = it >> 6;
                    conv_xs_wave(wl, CXBC + (size_t)b * CTXL * 3072, CTXL, cc, hb, CXT + ((size_t)((b * 2 + cc) * 2048 + hb * 64)) * 128, conv_w, conv_b, lane); }
              for (int it = gw; it < NB * 32 * 32; it += NGW) { const int hb = it & 31, cc = (it >> 5) & 31, b = it >> 10;
                    conv_xs_wave(wl, XBC + (size_t)b * SEQ * 3072, SEQ, cc, hb, XT + ((size_t)((b * 32 + cc) * 2048 + hb * 64)) * 128, conv_w, conv_b, lane); }
              for (int it = gw; it < NB * 64 * 16; it += NGW) { const int cq = it & 3, gi = (it >> 2) & 3, r = (it >> 4) & 63, b = it >> 10;
                    pool_wave(wl, V + (size_t)b * SEQ * 1024, DD + (size_t)b * SEQ * 1024, r, gi, cq, lane); } }
        PHASE_END
        PHASE_BEGIN(4)
            ssd_phase(lds, ws_l, d_skip, b0, vcu, G, tid);
        PHASE_END
        PHASE_BEGIN(5)
            for (int it = gw; it < T * 4; it += NGW) { const int gq = it & 3; const size_t m = (size_t)(it >> 2);
                gnorm_item(YF + m * 2048 + gq * 512, YB + m * 2048 + gq * 512, SZS + m * 2048 + gq * 512, ssd_norm + gq * 512, lane); }
            asm volatile("s_waitcnt vmcnt(0)" ::: "memory"); __syncthreads();
            { pg8::Gemm g{DD, PW, 1024, 256, 256, 256}; pg8::StaticOrder S; S.init(T, 1024, G, bx);
              EpiPool E{YP, SZP, pool_scale};
              pg8::gemm_phase<EpiPool, pg8::StaticOrder, true, true>(lds, g, S, E, tid); }
        PHASE_END
        PHASE_BEGIN(6)
            { pg8::Gemm g{YP, WPP, 1024, 1024, 1024, 0}; pg8::StaticOrder S; S.init(T, 1024, G, bx);
              EpiM1 E{outg, GATES};
              pg8::gemm_phase<EpiM1, pg8::StaticOrder, true, true>(lds, g, S, E, tid); }
            asm volatile("s_waitcnt vmcnt(0)" ::: "memory"); __syncthreads();
            { pg8::Gemm g{YF, WPS, 2048, 2048, 2048, 0}; pg8::StaticOrder S; S.init(T, 1024, G, bx);
              EpiM2 E{outg, GATES, MRG};
              pg8::gemm_phase<EpiM2, pg8::StaticOrder, true, true>(lds, g, S, E, tid); }
        PHASE_END
        PHASE_BEGIN(7)
            { pg8::Gemm g{MRG, WO, 1024, 1024, 1024, 0}; pg8::StaticOrder S; S.init(T, 1024, G, bx);
              EpiF32 E{outg};
              pg8::gemm_phase<EpiF32, pg8::StaticOrder, true, true>(lds, g, S, E, tid); }
        PHASE_END
        PHASE_BEGIN(8)
            for (int m = gw; m < T; m += NGW) { const size_t row = tok0 + m; final_row(out_p + row * 1024, x_in + row * 1024, norm_post, MOD + (row >> 12) * 3072 + 2048, lane); }
            if (grp + 1 < NGRP) for (int m = gw; m < T; m += NGW) { const size_t row = tok0 + T + m; modnorm_row(x_in + row * 1024, norm_pre, MOD + (row >> 12) * 3072, HX + (size_t)m * 1024, lane); }
        PHASE_END
    }
#undef PHASE_BEGIN
#undef PHASE_END
}

#undef x_in
#undef c_in
#undef ctx
#undef c_ctx
#undef w_ada
#undef b_ada
#undef norm_pre
#undef norm_post
#undef w_in
#undef b_merge
#undef pool_w
#undef pool_scale
#undef conv_w
#undef conv_b
#undef dt_bias
#undef a_log
#undef d_skip
#undef ssd_norm
#undef w_proj_pool
#undef w_proj_ssd
#undef w_out
#undef out_p
#undef WIN
#undef WPP
#undef WPS
#undef WO
#undef PW
#undef MOD
#undef HC
#undef CXBC
#undef CXT
#undef CBT
#undef CDT
#undef CDTV
#undef CACS
#undef HX
#undef V
#undef SZS
#undef GATES
#undef XBC
#undef DTR
#undef DTV
#undef ACS
#undef XT
#undef CG
#undef BT
#undef GT
#undef YF
#undef YP
#undef YB
#undef MRG
extern "C" void kernel_launch(void* const* d_in, const int* in_sizes, int n_in, void* d_out, int out_size, void* d_ws, size_t ws_size, hipStream_t stream) {
    static int grid = 0;
    if (grid == 0) {
        int dev = 0, cus = 0, per_cu = 0;
        (void)hipGetDevice(&dev); (void)hipDeviceGetAttribute(&cus, hipDeviceAttributeMultiprocessorCount, dev);
        (void)hipFuncSetAttribute((const void*)fwd_megakernel, hipFuncAttributeMaxDynamicSharedMemorySize, LDS_BYTES);
        (void)hipOccupancyMaxActiveBlocksPerMultiprocessor(&per_cu, (const void*)fwd_megakernel, NTHR, LDS_BYTES);
        if (per_cu < 1) per_cu = 1;
        grid = cus * per_cu;
        if (n_in != 21 || ws_size < WS_END) { fprintf(stderr, "kernel_launch: unexpected n_in %d / ws %zu\n", n_in, ws_size); }
        (void)hipGetLastError();
    }
    Args a{};
    for (int i = 0; i < 21; ++i) a.in[i] = (const float*)d_in[i];
    a.out = (float*)d_out; a.ws = (unsigned char*)d_ws; a.ph_lo = 0; a.ph_hi = 1 << 20;
    void* kargs[] = {&a};
    hipError_t e = hipLaunchCooperativeKernel((const void*)fwd_megakernel, dim3(grid), dim3(NTHR), kargs, LDS_BYTES, stream);
    if (e != hipSuccess) fprintf(stderr, "cooperative launch failed: %s (grid %d)\n", hipGetErrorString(e), grid);
}
```

```cpp
#include <hip/hip_runtime.h>
#include <hip/hip_cooperative_groups.h>
#include <cstdio>
#include <cstdint>
namespace cg = cooperative_groups;
namespace pg8 {
#define PG8_LAS __attribute__((address_space(3)))
typedef unsigned short bf16_t;
typedef short bf16x8 __attribute__((ext_vector_type(8)));
typedef float f32x4 __attribute__((ext_vector_type(4)));
typedef unsigned u32x4 __attribute__((ext_vector_type(4)));
constexpr int BM = 256, BK = 64, HALF = 128, HTB = HALF * BK * 2  , STAGE_BYTES = 8 * HTB, NXCD = 8, WGM = 8;

__host__ __device__ __forceinline__ int lds_byte(int r, int c) { const int st = (r >> 4) * 2 + (c >> 5), rr = r & 15, cc = c & 31, ob = rr * 64 + cc * 2; return st * 1024 + (ob ^ (((ob >> 9) & 1) << 5)); }
__host__ __device__ __forceinline__ void stage_rc(int b, int& R, int& C) { const int st = b / 1024, sb = b % 1024, swz = sb ^ (((sb >> 9) & 1) << 5); R = (st >> 1) * 16 + swz / 64; C = (st & 1) * 32 + (swz % 64) / 2; }
__host__ __device__ __forceinline__ int perm32(int rho) { const int n = rho >> 4, i = rho & 15; return 8 * (i >> 2) + 4 * n + (i & 3); }

struct Unit { int pm, pn; };
struct Gemm { const bf16_t* A; const bf16_t* Bt; int lda, ldb, K, a_pn_off; };
struct StaticOrder {
    int nM, nN, nwg, G, c;
    __host__ __device__ void init(int M, int N, int G_, int c_) { nM = M / BM; nN = N / BM; nwg = nM * nN; G = G_; c = c_; }
    __host__ __device__ bool next(int i, Unit& u) const {
        const long L = (long)i * G + c; if (L >= nwg) return false;
        int wgid = (int)L; { const int q = nwg / NXCD, r = nwg % NXCD, xcd = wgid % NXCD, off = wgid / NXCD; wgid = (xcd < r ? xcd * (q + 1) : r * (q + 1) + (xcd - r) * q) + off; }
        const int nig = WGM * nN, gid = wgid / nig, fm = gid * WGM, gsz = (nM - fm) < WGM ? (nM - fm) : WGM;
        u.pm = fm + ((wgid % nig) % gsz); u.pn = (wgid % nig) / gsz; return true;
    }
    __device__ __forceinline__ void a_ready(const Unit&) const {}
    __device__ __forceinline__ void done(const Unit&) const {}
};
typedef float f32x2_cv __attribute__((ext_vector_type(2)));
typedef __bf16 bf16x2_cv __attribute__((ext_vector_type(2)));
__device__ __forceinline__ unsigned cvt_pk_bf16(float lo, float hi) { const f32x2_cv v = {lo, hi}; const bf16x2_cv b = __builtin_convertvector(v, bf16x2_cv); return __builtin_bit_cast(unsigned, b); }
template <class Epi, class Sched, bool ALIGN_EPI = false, bool SP2 = false>
__device__ __forceinline__ void gemm_phase(PG8_LAS unsigned char* lds, const Gemm g, const Sched& S, const Epi& E, int tid_in) {
    int tid_l = tid_in; asm volatile("" : "+v"(tid_l));
    const int tid = tid_l, wid = __builtin_amdgcn_readfirstlane(tid >> 6), lane = tid & 63, wr = wid >> 2, wc = wid & 3, fr = lane & 15, fq = lane >> 4;
    const int K = g.K, nt = K / BK;
    unsigned voffA[2], voffB[2];
#pragma unroll
    for (int i = 0; i < 2; ++i) { int R, C; stage_rc(tid * 16 + i * 8192, R, C); const int Rb = Epi::PERM ? ((R & ~31) + perm32(R & 31)) : R;
        voffA[i] = (unsigned)(R * g.lda + C) * 2u; voffB[i] = (unsigned)(Rb * g.ldb + C) * 2u; }
    const size_t kstep = (size_t)(BK * 2);
    const size_t hstepA = (size_t)HALF * g.lda * 2, hstepB = (size_t)HALF * g.ldb * 2;
    const size_t tstepA = 2 * hstepA, tstepB = 2 * hstepB, pnoffA = (size_t)g.a_pn_off * 2;
    const unsigned ldsw = (unsigned)wid * 1024u;
    const int aoff = lds_byte(wr * 64 + fr, fq * 8), boff = lds_byte(wc * 32 + fr, fq * 8);
#define PG8_SA(b, h) (((b) * 2 + (h)) * HTB)
#define PG8_SB(b, h) ((4 + (b) * 2 + (h)) * HTB)
#define PG8_STAGE(bufoff, gbase, voff) do { _Pragma("unroll") for (int _i = 0; _i < 2; ++_i) \
        __builtin_amdgcn_global_load_lds((const unsigned*)((const char*)(gbase) + (voff)[_i]), (PG8_LAS unsigned*)(lds + (bufoff) + ldsw + _i * 8192), 16, 0, 0); } while (0)
#define PG8_LDA(dst, b, h) do { _Pragma("unroll") for (int m = 0; m < 4; ++m) _Pragma("unroll") for (int k = 0; k < 2; ++k) dst[m][k] = *(const PG8_LAS bf16x8*)(lds + PG8_SA(b, h) + aoff + m * 2048 + k * 1024); } while (0)
#define PG8_LDB(dst, b, h) do { _Pragma("unroll") for (int n = 0; n < 2; ++n) _Pragma("unroll") for (int k = 0; k < 2; ++k) dst[n][k] = *(const PG8_LAS bf16x8*)(lds + PG8_SB(b, h) + boff + n * 2048 + k * 1024); } while (0)
#define PG8_MMA(ai, bj, At, Bt) do { __builtin_amdgcn_s_setprio(1); _Pragma("unroll") for (int m = 0; m < 4; ++m) _Pragma("unroll") for (int n = 0; n < 2; ++n) _Pragma("unroll") for (int k = 0; k < 2; ++k) \
        acc[ai][bj][m][n] = __builtin_amdgcn_mfma_f32_16x16x32_bf16(Bt[n][k], At[m][k], acc[ai][bj][m][n], 0, 0, 0); __builtin_amdgcn_s_setprio(0); } while (0)
#define PG8_WAIT_V(n) asm volatile("s_waitcnt vmcnt(" #n ")" ::: "memory")
#define PG8_WAIT_L(n) asm volatile("s_waitcnt lgkmcnt(" #n ")" ::: "memory")
#define PG8_BAR __builtin_amdgcn_s_barrier()
#define PG8_SCHED __builtin_amdgcn_sched_barrier(0)
    Unit cur, nxt; int ui = 0;
    if (!S.next(0, cur)) return;
    f32x4 acc[2][2][4][2];
#pragma unroll
    for (int a = 0; a < 2; ++a)
#pragma unroll
        for (int b = 0; b < 2; ++b)
#pragma unroll
            for (int m = 0; m < 4; ++m)
#pragma unroll
                for (int n = 0; n < 2; ++n) acc[a][b][m][n] = (f32x4){0.f, 0.f, 0.f, 0.f};
    bf16x8 At[4][2], B0[2][2], B1[2][2];
    const char* cA = (const char*)g.A + (size_t)cur.pm * tstepA + (size_t)cur.pn * pnoffA; const char* cB = (const char*)g.Bt + (size_t)cur.pn * tstepB;
    S.a_ready(cur);
    if constexpr (SP2) {
        PG8_STAGE(PG8_SB(0, 0), cB, voffB); PG8_STAGE(PG8_SB(0, 1), cB + hstepB, voffB); PG8_STAGE(PG8_SA(0, 0), cA, voffA); PG8_STAGE(PG8_SA(0, 1), cA + hstepA, voffA);
        if (wr == 1) PG8_BAR;
        PG8_WAIT_V(2); PG8_BAR;
        PG8_STAGE(PG8_SB(1, 0), cB + kstep, voffB); PG8_STAGE(PG8_SA(1, 0), cA + kstep, voffA); PG8_STAGE(PG8_SB(1, 1), cB + hstepB + kstep, voffB);
        PG8_WAIT_V(6); PG8_BAR;
    } else {
        PG8_STAGE(PG8_SB(0, 0), cB, voffB); PG8_STAGE(PG8_SA(0, 0), cA, voffA); PG8_STAGE(PG8_SB(0, 1), cB + hstepB, voffB); PG8_STAGE(PG8_SA(0, 1), cA + hstepA, voffA);
        if (wr == 1) PG8_BAR;
        PG8_WAIT_V(4); PG8_BAR;
        PG8_STAGE(PG8_SB(1, 0), cB + kstep, voffB); PG8_STAGE(PG8_SA(1, 0), cA + kstep, voffA); PG8_STAGE(PG8_SB(1, 1), cB + hstepB + kstep, voffB);
        PG8_WAIT_V(6); PG8_BAR;
    }
    for (;;) {
        const bool has_next = S.next(ui + 1, nxt);
        const char* nA = has_next ? (const char*)g.A + (size_t)nxt.pm * tstepA + (size_t)nxt.pn * pnoffA : cA; const char* nB = has_next ? (const char*)g.Bt + (size_t)nxt.pn * tstepB : cB;
        for (int t = 0; t < nt; t += 2) {
            const bool last = (t == nt - 2);
            const char* a1 = cA + (size_t)(t + 1) * kstep;
            const char* a2 = last ? nA : cA + (size_t)(t + 2) * kstep; const char* b2 = last ? nB : cB + (size_t)(t + 2) * kstep;
            const char* a3 = a2 + kstep; const char* b3 = b2 + kstep;
            if (last && has_next) S.a_ready(nxt);
            if constexpr (SP2) {
            PG8_LDB(B0, 0, 0); PG8_LDB(B1, 0, 1); PG8_SCHED; PG8_LDA(At, 0, 0); PG8_STAGE(PG8_SA(1, 1), a1 + hstepA, voffA);
            PG8_WAIT_V(8); PG8_WAIT_L(0); PG8_BAR; PG8_MMA(0, 0, At, B0); PG8_MMA(0, 1, At, B1); PG8_BAR; PG8_SCHED;
            PG8_LDA(At, 0, 1); PG8_STAGE(PG8_SB(0, 0), b2, voffB); PG8_STAGE(PG8_SB(0, 1), b2 + hstepB, voffB); PG8_STAGE(PG8_SA(0, 0), a2, voffA);
            PG8_WAIT_V(8); PG8_WAIT_L(0); PG8_BAR; PG8_MMA(1, 0, At, B0); PG8_MMA(1, 1, At, B1); PG8_BAR; PG8_SCHED;
            PG8_LDB(B0, 1, 0); PG8_LDB(B1, 1, 1); PG8_SCHED; PG8_LDA(At, 1, 0); PG8_STAGE(PG8_SA(0, 1), a2 + hstepA, voffA);
            PG8_WAIT_V(8); PG8_WAIT_L(0); PG8_BAR; PG8_MMA(0, 0, At, B0); PG8_MMA(0, 1, At, B1); PG8_BAR; PG8_SCHED;
            PG8_LDA(At, 1, 1); PG8_STAGE(PG8_SB(1, 0), b3, voffB); PG8_STAGE(PG8_SB(1, 1), b3 + hstepB, voffB); PG8_STAGE(PG8_SA(1, 0), a3, voffA);
            PG8_WAIT_V(8); PG8_WAIT_L(0); PG8_BAR; PG8_MMA(1, 0, At, B0); PG8_MMA(1, 1, At, B1); PG8_BAR; PG8_SCHED;
            } else {
            PG8_LDB(B0, 0, 0); PG8_SCHED; PG8_LDA(At, 0, 0); PG8_STAGE(PG8_SA(1, 1), a1 + hstepA, voffA);
            PG8_WAIT_L(8); PG8_BAR; PG8_WAIT_L(0); PG8_MMA(0, 0, At, B0); PG8_BAR; PG8_SCHED;
            PG8_LDB(B1, 0, 1); PG8_STAGE(PG8_SB(0, 0), b2, voffB);
            PG8_BAR; PG8_WAIT_L(0); PG8_MMA(0, 1, At, B1); PG8_BAR;
            PG8_LDA(At, 0, 1); PG8_STAGE(PG8_SA(0, 0), a2, voffA);
            PG8_BAR; PG8_WAIT_L(0); PG8_MMA(1, 0, At, B0); PG8_BAR; PG8_SCHED;
            PG8_STAGE(PG8_SB(0, 1), b2 + hstepB, voffB);
            PG8_WAIT_V(6); PG8_BAR; PG8_MMA(1, 1, At, B1); PG8_BAR;
            PG8_LDB(B0, 1, 0); PG8_SCHED; PG8_LDA(At, 1, 0); PG8_STAGE(PG8_SA(0, 1), a2 + hstepA, voffA);
            PG8_WAIT_L(8); PG8_BAR; PG8_WAIT_L(0); PG8_MMA(0, 0, At, B0); PG8_BAR; PG8_SCHED;
            PG8_LDB(B1, 1, 1); PG8_STAGE(PG8_SB(1, 0), b3, voffB);
            PG8_BAR; PG8_WAIT_L(0); PG8_MMA(0, 1, At, B1); PG8_BAR;
            PG8_LDA(At, 1, 1); PG8_STAGE(PG8_SA(1, 0), a3, voffA);
            PG8_BAR; PG8_WAIT_L(0); PG8_MMA(1, 0, At, B0); PG8_BAR; PG8_SCHED;
            PG8_STAGE(PG8_SB(1, 1), b3 + hstepB, voffB);
            PG8_WAIT_V(6); PG8_BAR; PG8_MMA(1, 1, At, B1); PG8_BAR;
            }
        }
        if constexpr (ALIGN_EPI) { if (wr == 0) PG8_BAR; }
        if constexpr (!Epi::AFTER_DRAIN) { E(acc, cur, wr, wc, fr, fq); S.done(cur); }
        if (!has_next) break;
#pragma unroll
        for (int a = 0; a < 2; ++a)
#pragma unroll
            for (int b = 0; b < 2; ++b)
#pragma unroll
                for (int m = 0; m < 4; ++m)
#pragma unroll
                    for (int n = 0; n < 2; ++n) acc[a][b][m][n] = (f32x4){0.f, 0.f, 0.f, 0.f};
        cur = nxt; cA = nA; cB = nB; ++ui;
        if constexpr (ALIGN_EPI) { if (wr == 1) PG8_BAR; }
    }
    PG8_WAIT_V(0);
    if constexpr (!ALIGN_EPI) { if (wr == 0) PG8_BAR; }
    PG8_BAR;
    if constexpr (Epi::AFTER_DRAIN) { E.fused(acc, cur, wr, wc, fr, fq, lds, wid, lane); S.done(cur); }
#undef PG8_SA
#undef PG8_SB
#undef PG8_STAGE
#undef PG8_LDA
#undef PG8_LDB
#undef PG8_MMA
#undef PG8_WAIT_V
#undef PG8_WAIT_L
#undef PG8_BAR
#undef PG8_SCHED
}
}
using pg8::bf16_t; using pg8::bf16x8; using pg8::f32x4; using pg8::u32x4; using pg8::cvt_pk_bf16;
#define LAS __attribute__((address_space(3)))
typedef unsigned u32x2 __attribute__((ext_vector_type(2)));
#define DI __device__ __forceinline__

constexpr int D = 1024, BATCH = 16, SEQ = 4096, CTXL = 256, NH = 32;
constexpr int INP = 9472;
constexpr int NB = 8, T = NB * SEQ, NGRP = BATCH / NB, CT = BATCH * CTXL;
constexpr float EPS = 1e-6f;
constexpr int NTHR = 512;
constexpr int LDS_BYTES = 147456;

constexpr size_t MiB = 1u << 20;
constexpr size_t al256(size_t x) { return (x + 255) & ~(size_t)255; }
constexpr size_t WS_WIN = 0;
constexpr size_t WS_WPP = WS_WIN + al256((size_t)INP * 1024 * 2);
constexpr size_t WS_WPS = WS_WPP + 2 * MiB;
constexpr size_t WS_WO = WS_WPS + 4 * MiB;
constexpr size_t WS_PW = WS_WO + 2 * MiB;
constexpr size_t WS_MOD = WS_PW + MiB / 2;
constexpr size_t WS_HC = WS_MOD + al256(17 * 3072 * 4);
constexpr size_t WS_CXBC = WS_HC + (size_t)CT * 1024 * 2;
constexpr size_t WS_CDT = WS_CXBC + (size_t)CT * 3072 * 2;
constexpr size_t WS_CXT = WS_CDT + (size_t)CT * 64 * 4;
constexpr size_t WS_CBT = WS_CXT + (size_t)CT * 2048 * 2;
constexpr size_t WS_CDTV = WS_CBT + (size_t)CT * 512 * 2;
constexpr size_t WS_CACS = WS_CDTV + (size_t)2 * CT * 32 * 4;
constexpr size_t WS_HX = WS_CACS + (size_t)2 * CT * 32 * 4;
constexpr size_t WS_V = WS_HX + (size_t)T * 1024 * 2;
constexpr size_t WS_SZS = WS_V + (size_t)T * 1024 * 2;
constexpr size_t WS_GATES = WS_SZS + (size_t)T * 2048 * 2;
constexpr size_t WS_XBC = WS_GATES + (size_t)T * 2048 * 2;
constexpr size_t WS_DTR = WS_XBC + (size_t)T * 3072 * 2;
constexpr size_t WS_XT = WS_DTR + (size_t)T * 64 * 4;
constexpr size_t WS_CG = WS_XT + (size_t)T * 2048 * 2;
constexpr size_t WS_BT = WS_CG + (size_t)T * 512 * 2;
constexpr size_t WS_GT = WS_BT + (size_t)T * 512 * 2;
constexpr size_t WS_DTV = WS_GT + (size_t)T * 512 * 2;
constexpr size_t WS_ACS = WS_DTV + (size_t)2 * T * 32 * 4;
constexpr size_t WS_END = WS_ACS + (size_t)2 * T * 32 * 4;
constexpr size_t WS_BAR = al256(WS_END);
constexpr size_t WS_YF = WS_XBC, WS_YP = WS_XBC + (size_t)T * 2048 * 2, WS_YB = WS_HX, WS_MRG = WS_HX;
static_assert(WS_BAR + 16384 <= 1024 * MiB, "workspace map");

DI float bflo(unsigned w) { return __uint_as_float(w << 16); }
DI float bfhi(unsigned w) { return __uint_as_float(w & 0xffff0000u); }
DI float silu_f(float x) { return x * __builtin_amdgcn_rcpf(1.f + __expf(-x)); }
DI float sigm_f(float x) { return __builtin_amdgcn_rcpf(1.f + __expf(-x)); }
DI float wave_sum(float v, int lane) {
#pragma unroll
    for (int o = 1; o < 64; o <<= 1) v += __int_as_float(__builtin_amdgcn_ds_bpermute((lane ^ o) << 2, __float_as_int(v)));
    return v;
}
DI u32x4 pack8(const float* o) { u32x4 w; w.x = cvt_pk_bf16(o[0], o[1]); w.y = cvt_pk_bf16(o[2], o[3]); w.z = cvt_pk_bf16(o[4], o[5]); w.w = cvt_pk_bf16(o[6], o[7]); return w; }
DI void unpack8(u32x4 w, float* o) { o[0] = bflo(w.x); o[1] = bfhi(w.x); o[2] = bflo(w.y); o[3] = bfhi(w.y); o[4] = bflo(w.z); o[5] = bfhi(w.z); o[6] = bflo(w.w); o[7] = bfhi(w.w); }
#define MFMA16(a, b, c) __builtin_amdgcn_mfma_f32_16x16x32_bf16((a), (b), (c), 0, 0, 0)

DI int fresh_lane() { unsigned m = ~0u; asm volatile("" : "+s"(m)); int l = (int)__builtin_amdgcn_mbcnt_hi(m, __builtin_amdgcn_mbcnt_lo(m, 0u)); asm volatile("" : "+v"(l)); return l; }
struct EpiInProj {
    static constexpr bool PERM = true, AFTER_DRAIN = false;
    bf16_t *V, *SZP, *SZS, *GATES, *XBC; float* DT; const float* b_merge; int pn_base;
    __device__ __forceinline__ void operator()(const f32x4 (&acc)[2][2][4][2], const pg8::Unit& u, int wr, int wc, int, int) const { const int ln_ = fresh_lane(), fr = ln_ & 15, fq = ln_ >> 4;
        const int pn = u.pn + pn_base; int mode, ldc, colt; bf16_t* O;
        if (pn < 4) { mode = 0; O = V; ldc = 1024; colt = pn * 256; }
        else if (pn < 8) { mode = 1; O = SZP; ldc = 1024; colt = (pn - 4) * 256; }
        else if (pn < 16) { mode = 1; O = SZS; ldc = 2048; colt = (pn - 8) * 256; }
        else if (pn < 24) { mode = 2; O = GATES; ldc = 2048; colt = (pn - 16) * 256; }
        else if (pn < 36) { mode = 0; O = XBC; ldc = 3072; colt = (pn - 24) * 256; }
        else { mode = 3; O = nullptr; ldc = 64; colt = 0; }
        const int row0 = u.pm * 256 + wr * 64 + fr;
        if (mode == 3) {
            if (wc < 2) {
#pragma unroll
                for (int ai = 0; ai < 2; ++ai)
#pragma unroll
                    for (int m = 0; m < 4; ++m) { float* rp = DT + (size_t)(row0 + ai * 128 + m * 16) * 64 + wc * 32 + 8 * fq;
                        *(f32x4*)rp = acc[ai][0][m][0]; *(f32x4*)(rp + 4) = acc[ai][0][m][1]; }
            }
            return;
        }
        const int col0 = colt + wc * 32 + 8 * fq;
#define INPROJ_WALK(...) \
        _Pragma("unroll") for (int ai = 0; ai < 2; ++ai) _Pragma("unroll") for (int m = 0; m < 4; ++m) { bf16_t* rowp = O + (size_t)(row0 + ai * 128 + m * 16) * ldc + col0; \
            _Pragma("unroll") for (int bj = 0; bj < 2; ++bj) { f32x4 v0 = acc[ai][bj][m][0], v1 = acc[ai][bj][m][1]; __VA_ARGS__ \
                u32x4 w; w.x = cvt_pk_bf16(v0[0], v0[1]); w.y = cvt_pk_bf16(v0[2], v0[3]); w.z = cvt_pk_bf16(v1[0], v1[1]); w.w = cvt_pk_bf16(v1[2], v1[3]); \
                *(u32x4*)(rowp + bj * 128) = w; } asm volatile("" ::: "memory"); }
        if (mode == 0) { INPROJ_WALK() }
        else if (mode == 1) { INPROJ_WALK(_Pragma("unroll") for (int e = 0; e < 4; ++e) { v0[e] = silu_f(v0[e]); v1[e] = silu_f(v1[e]); }) }
        else { INPROJ_WALK({ const f32x4 b0 = *(const f32x4*)(b_merge + col0 + bj * 128), b1 = *(const f32x4*)(b_merge + col0 + bj * 128 + 4);
                 _Pragma("unroll") for (int e = 0; e < 4; ++e) { v0[e] = sigm_f(v0[e] + b0[e]); v1[e] = sigm_f(v1[e] + b1[e]); } }) }
#undef INPROJ_WALK
    }
};
#define EPI_WALK(...) \
    const int row0_ = u.pm * 256 + wr * 64 + fr, col0_ = u.pn * 256 + wc * 32 + 8 * fq; \
    _Pragma("unroll") for (int ai = 0; ai < 2; ++ai) _Pragma("unroll") for (int m = 0; m < 4; ++m) { const size_t row = (size_t)(row0_ + ai * 128 + m * 16); \
    _Pragma("unroll") for (int bj = 0; bj < 2; ++bj) { const int col = col0_ + bj * 128; const f32x4 v0 = acc[ai][bj][m][0], v1 = acc[ai][bj][m][1]; __VA_ARGS__ } asm volatile("" ::: "memory"); }

struct EpiPool {
    static constexpr bool PERM = true, AFTER_DRAIN = false;
    bf16_t* YP; const bf16_t* SZP; const float* pscale;
    __device__ __forceinline__ void operator()(const f32x4 (&acc)[2][2][4][2], const pg8::Unit& u, int wr, int wc, int, int) const { const int ln_ = fresh_lane(), fr = ln_ & 15, fq = ln_ >> 4;
        EPI_WALK({ const f32x4 s0 = *(const f32x4*)(pscale + col), s1 = *(const f32x4*)(pscale + col + 4); float z[8]; unpack8(*(const u32x4*)(SZP + row * 1024 + col), z);
            float o[8]; o[0] = v0[0] * s0[0] * z[0]; o[1] = v0[1] * s0[1] * z[1]; o[2] = v0[2] * s0[2] * z[2]; o[3] = v0[3] * s0[3] * z[3];
            o[4] = v1[0] * s1[0] * z[4]; o[5] = v1[1] * s1[1] * z[5]; o[6] = v1[2] * s1[2] * z[6]; o[7] = v1[3] * s1[3] * z[7];
            *(u32x4*)(YP + row * 1024 + col) = pack8(o); })
    }
};
struct EpiM1 {
    static constexpr bool PERM = true, AFTER_DRAIN = false;
    float* TMP; const bf16_t* GATES;
    __device__ __forceinline__ void operator()(const f32x4 (&acc)[2][2][4][2], const pg8::Unit& u, int wr, int wc, int, int) const { const int ln_ = fresh_lane(), fr = ln_ & 15, fq = ln_ >> 4;
        EPI_WALK({ float gt[8]; unpack8(*(const u32x4*)(GATES + row * 2048 + col), gt);
            f32x4 o0, o1; o0[0] = v0[0] * gt[0]; o0[1] = v0[1] * gt[1]; o0[2] = v0[2] * gt[2]; o0[3] = v0[3] * gt[3]; o1[0] = v1[0] * gt[4]; o1[1] = v1[1] * gt[5]; o1[2] = v1[2] * gt[6]; o1[3] = v1[3] * gt[7];
            *(f32x4*)(TMP + row * 1024 + col) = o0; *(f32x4*)(TMP + row * 1024 + col + 4) = o1; })
    }
};
struct EpiM2 {
    static constexpr bool PERM = true, AFTER_DRAIN = false;
    const float* TMP; const bf16_t* GATES; bf16_t* MRG;
    __device__ __forceinline__ void operator()(const f32x4 (&acc)[2][2][4][2], const pg8::Unit& u, int wr, int wc, int, int) const { const int ln_ = fresh_lane(), fr = ln_ & 15, fq = ln_ >> 4;
        EPI_WALK({ float gt[8]; unpack8(*(const u32x4*)(GATES + row * 2048 + 1024 + col), gt);
            const f32x4 t0 = *(const f32x4*)(TMP + row * 1024 + col), t1 = *(const f32x4*)(TMP + row * 1024 + col + 4);
            float o[8]; o[0] = t0[0] + v0[0] * gt[0]; o[1] = t0[1] + v0[1] * gt[1]; o[2] = t0[2] + v0[2] * gt[2]; o[3] = t0[3] + v0[3] * gt[3];
            o[4] = t1[0] + v1[0] * gt[4]; o[5] = t1[1] + v1[1] * gt[5]; o[6] = t1[2] + v1[2] * gt[6]; o[7] = t1[3] + v1[3] * gt[7];
            *(u32x4*)(MRG + row * 1024 + col) = pack8(o); })
    }
};
struct EpiF32 {
    static constexpr bool PERM = true, AFTER_DRAIN = false;
    float* O;
    __device__ __forceinline__ void operator()(const f32x4 (&acc)[2][2][4][2], const pg8::Unit& u, int wr, int wc, int, int) const { const int ln_ = fresh_lane(), fr = ln_ & 15, fq = ln_ >> 4;
        EPI_WALK({ *(f32x4*)(O + row * 1024 + col) = v0; *(f32x4*)(O + row * 1024 + col + 4) = v1; })
    }
};
DI void transpose_item(const float* W, int K, int N, bf16_t* WT, int ldo, int row_off, LAS float* scr, int item, int lane) {
    const int nblk = N / 32, kb = item / nblk, nb = item % nblk, k0 = 64 * kb, n0 = 32 * nb;
#pragma unroll 8
    for (int i = 0; i < 32; ++i) { const int kk = 2 * i + (lane >> 5); scr[kk * 33 + (lane & 31)] = W[(size_t)(k0 + kk) * N + n0 + (lane & 31)]; }
    asm volatile("s_waitcnt lgkmcnt(0)" ::: "memory");
    const int c = lane & 7;
#pragma unroll
    for (int j = 0; j < 4; ++j) { const int n = (lane >> 3) + 8 * j; const LAS float* s = scr + (8 * c) * 33 + n;
        u32x4 o; o.x = cvt_pk_bf16(s[0 * 33], s[1 * 33]); o.y = cvt_pk_bf16(s[2 * 33], s[3 * 33]); o.z = cvt_pk_bf16(s[4 * 33], s[5 * 33]); o.w = cvt_pk_bf16(s[6 * 33], s[7 * 33]);
        *(u32x4*)(WT + (size_t)(row_off + n0 + n) * ldo + k0 + 8 * c) = o; }
    asm volatile("s_waitcnt lgkmcnt(0)" ::: "memory");
}
DI void mod_item(LAS unsigned char* lds, const float* c, const float* c_ctx, const float* w_ada, const float* b_ada, float* MOD, int item, int tid) {
    LAS float* sS = (LAS float*)lds;
    LAS float* sP = (LAS float*)(lds + 17 * 1024 * 4);
    for (int i = tid; i < 17 * 1024; i += NTHR) { const float v = i < 16 * 1024 ? c[i] : c_ctx[i - 16 * 1024]; sS[i] = silu_f(v); }
    __syncthreads();
    const int col = tid & 63, kseg = tid >> 6, n = item * 64 + col;
    float acc[17];
#pragma unroll
    for (int r = 0; r < 17; ++r) acc[r] = 0.f;
    for (int k = kseg * 128; k < kseg * 128 + 128; ++k) { const float w = w_ada[(size_t)k * 3072 + n];
#pragma unroll
        for (int r = 0; r < 17; ++r) acc[r] += sS[r * 1024 + k] * w; }
#pragma unroll
    for (int r = 0; r < 17; ++r) sP[(kseg * 17 + r) * 64 + col] = acc[r];
    __syncthreads();
    for (int i = tid; i < 17 * 64; i += NTHR) { const int r = i >> 6, cc = i & 63; float s = b_ada[item * 64 + cc];
#pragma unroll
        for (int q = 0; q < 8; ++q) s += sP[(q * 17 + r) * 64 + cc];
        MOD[r * 3072 + item * 64 + cc] = s; }
    __syncthreads();
}
DI void modnorm_row(const float* xrow, const float* npre, const float* mod, bf16_t* orow, int lane) {
    f32x4 v[4]; float ss = 0.f;
#pragma unroll
    for (int j = 0; j < 4; ++j) { v[j] = *(const f32x4*)(xrow + 4 * lane + 256 * j); ss += (v[j].x * v[j].x + v[j].y * v[j].y) + (v[j].z * v[j].z + v[j].w * v[j].w); }
    const float rstd = rsqrtf(wave_sum(ss, lane) * (1.f / 1024.f) + EPS);
#pragma unroll
    for (int j = 0; j < 4; ++j) { const int c0 = 4 * lane + 256 * j; const f32x4 w = *(const f32x4*)(npre + c0), sh = *(const f32x4*)(mod + c0), sc = *(const f32x4*)(mod + 1024 + c0);
        f32x4 o;
#pragma unroll
        for (int e = 0; e < 4; ++e) o[e] = v[j][e] * rstd * w[e] * (1.f + sc[e]) + sh[e];
        u32x2 p; p.x = cvt_pk_bf16(o[0], o[1]); p.y = cvt_pk_bf16(o[2], o[3]); *(u32x2*)(orow + c0) = p; }
}
DI void final_row(float* yrow, const float* xrow, const float* npost, const float* gate, int lane) {
    f32x4 v[4]; float ss = 0.f;
#pragma unroll
    for (int j = 0; j < 4; ++j) { v[j] = *(const f32x4*)(yrow + 4 * lane + 256 * j); ss += (v[j].x * v[j].x + v[j].y * v[j].y) + (v[j].z * v[j].z + v[j].w * v[j].w); }
    const float rstd = rsqrtf(wave_sum(ss, lane) * (1.f / 1024.f) + EPS);
#pragma unroll
    for (int j = 0; j < 4; ++j) { const int c0 = 4 * lane + 256 * j; const f32x4 w = *(const f32x4*)(npost + c0), g = *(const f32x4*)(gate + c0), x = *(const f32x4*)(xrow + c0);
        f32x4 o;
#pragma unroll
        for (int e = 0; e < 4; ++e) o[e] = x[e] + g[e] * (v[j][e] * rstd * w[e]);
        *(f32x4*)(yrow + c0) = o; }
}
DI void gnorm_item(bf16_t* yf, const bf16_t* yb, const bf16_t* szs, const float* w, int lane) {
    float a[8], b[8], z[8], u[8]; unpack8(*(const u32x4*)(yf + lane * 8), a); unpack8(*(const u32x4*)(yb + lane * 8), b); unpack8(*(const u32x4*)(szs + lane * 8), z);
    float ss = 0.f;
#pragma unroll
    for (int e = 0; e < 8; ++e) { u[e] = (a[e] + b[e]) * z[e]; ss += u[e] * u[e]; }
    const float r = rsqrtf(wave_sum(ss, lane) * (1.f / 512.f) + EPS);
    const f32x4 w0 = *(const f32x4*)(w + lane * 8), w1 = *(const f32x4*)(w + lane * 8 + 4);
    float o[8];
#pragma unroll
    for (int e = 0; e < 4; ++e) { o[e] = u[e] * r * w0[e]; o[4 + e] = u[4 + e] * r * w1[e]; }
    *(u32x4*)(yf + lane * 8) = pack8(o);
}

constexpr int RS = 272;
DI void conv_xs_wave(LAS unsigned char* wl, const bf16_t* src, int L, int c, int hb, bf16_t* dst_tile, const float* conv_w, const float* conv_b, int lane) {
    const int cp = lane & 31, th = lane >> 5, ch = hb * 64 + 2 * cp;
    float w0[4], w1[4];
#pragma unroll
    for (int k = 0; k < 4; ++k) { w0[k] = conv_w[k * 3072 + ch]; w1[k] = conv_w[k * 3072 + ch + 1]; }
    const float b0 = conv_b[ch], b1 = conv_b[ch + 1];
    const int t0 = c * 128 + th * 64 - 2;
    unsigned raw[67];
#pragma unroll
    for (int r = 0; r < 67; ++r) { const int t = t0 + r; raw[r] = 0u; if (t >= 0 && t < L) raw[r] = *(const unsigned*)(src + (size_t)t * 3072 + ch); }
#pragma unroll
    for (int blk = 0; blk < 8; ++blk) { float o0[8], o1[8];
#pragma unroll
        for (int u = 0; u < 8; ++u) { float s0 = b0, s1 = b1;
#pragma unroll
            for (int k = 0; k < 4; ++k) { s0 += w0[k] * bflo(raw[blk * 8 + u + k]); s1 += w1[k] * bfhi(raw[blk * 8 + u + k]); }
            o0[u] = silu_f(s0); o1[u] = silu_f(s1); }
        *(LAS u32x4*)(wl + (2 * cp) * RS + (th * 64 + blk * 8) * 2) = pack8(o0);
        *(LAS u32x4*)(wl + (2 * cp + 1) * RS + (th * 64 + blk * 8) * 2) = pack8(o1); }
    asm volatile("s_waitcnt lgkmcnt(0)" ::: "memory");
#pragma unroll
    for (int q = 0; q < 16; ++q) { const int row = q * 4 + (lane >> 4), cb = (lane & 15) * 16;
        *(u32x4*)((char*)dst_tile + row * 256 + cb) = *(const LAS u32x4*)(wl + row * RS + cb); }
    asm volatile("s_waitcnt lgkmcnt(0)" ::: "memory");
}
DI void conv_bc_item(LAS unsigned char* lds, const bf16_t* src, int L, int c, int g, bf16_t* bt_tile, bf16_t* cg_rows, bf16_t* gt_tile, const float* conv_w, const float* conv_b, int tid) {
    LAS unsigned char* sB = lds; LAS unsigned char* sC = lds + 128 * RS;
    {
        const int p_ = tid & 127, tq = tid >> 7, mat = p_ >> 6, n2 = 2 * (p_ & 63), ch = 2048 + mat * 512 + g * 128 + n2;
        LAS unsigned char* sM = mat ? sC : sB;
        float w0[4], w1[4];
#pragma unroll
        for (int k = 0; k < 4; ++k) { w0[k] = conv_w[k * 3072 + ch]; w1[k] = conv_w[k * 3072 + ch + 1]; }
        const float b0 = conv_b[ch], b1 = conv_b[ch + 1];
        unsigned raw[4][11];
#pragma unroll
        for (int ps = 0; ps < 4; ++ps)
#pragma unroll
            for (int r = 0; r < 11; ++r) { const int t = c * 128 + (ps * 4 + tq) * 8 - 2 + r; raw[ps][r] = 0u; if (t >= 0 && t < L) raw[ps][r] = *(const unsigned*)(src + (size_t)t * 3072 + ch); }
#pragma unroll
        for (int ps = 0; ps < 4; ++ps) { const int tk0 = (ps * 4 + tq) * 8; float o0[8], o1[8];
#pragma unroll
            for (int u = 0; u < 8; ++u) { float s0 = b0, s1 = b1;
#pragma unroll
                for (int k = 0; k < 4; ++k) { s0 += w0[k] * bflo(raw[ps][u + k]); s1 += w1[k] * bfhi(raw[ps][u + k]); }
                o0[u] = silu_f(s0); o1[u] = silu_f(s1);
                *(LAS unsigned*)(sM + (tk0 + u) * RS + n2 * 2) = cvt_pk_bf16(o0[u], o1[u]); }
            if (mat == 0) { *(u32x4*)(bt_tile + (size_t)n2 * 128 + tk0) = pack8(o0); *(u32x4*)(bt_tile + (size_t)(n2 + 1) * 128 + tk0) = pack8(o1); } }
    }
    __syncthreads();
    if (cg_rows) { const int row = tid >> 2, cb = (tid & 3) * 64;
#pragma unroll
        for (int q = 0; q < 4; ++q) *(u32x4*)((char*)(cg_rows + (size_t)row * 512) + cb + q * 16) = *(const LAS u32x4*)(sC + row * RS + cb + q * 16); }
    if (gt_tile) { const int wid = tid >> 6, lane = tid & 63, fr = lane & 15, fq = lane >> 4;
        f32x4 acc[8];
#pragma unroll
        for (int jb = 0; jb < 8; ++jb) acc[jb] = (f32x4){0.f, 0.f, 0.f, 0.f};
#pragma unroll
        for (int ks = 0; ks < 4; ++ks) { const bf16x8 cf = *(const LAS bf16x8*)(sC + (16 * wid + fr) * RS + (ks * 32 + fq * 8) * 2);
#pragma unroll
            for (int jb = 0; jb < 8; ++jb) { const bf16x8 bfr = *(const LAS bf16x8*)(sB + (jb * 16 + fr) * RS + (ks * 32 + fq * 8) * 2); acc[jb] = MFMA16(bfr, cf, acc[jb]); } }
#pragma unroll
        for (int jb = 0; jb < 8; ++jb) { u32x2 p; p.x = cvt_pk_bf16(acc[jb][0], acc[jb][1]); p.y = cvt_pk_bf16(acc[jb][2], acc[jb][3]);
            *(u32x2*)(gt_tile + (size_t)(16 * wid + fr) * 128 + jb * 16 + fq * 4) = p; } }
    __syncthreads();
}
DI void dt_item(LAS unsigned char* lds, const float* dtr, int L, int c, float* dtv, float* acs, size_t dir_stride, const float* dt_bias, const float* a_log, int tid) {
    LAS float* sTot = (LAS float*)lds;
    const int col = tid & 63, seg = tid >> 6, dir = col >> 5, h = col & 31;
    const float bias = dt_bias[col], A = -__expf(a_log[col]);
    float dtl[16], cs[16];
#pragma unroll
    for (int u = 0; u < 16; ++u) { const float x = dtr[(size_t)(c * 128 + seg * 16 + u) * 64 + col] + bias; dtl[u] = x > 20.f ? x : log1pf(expf(x)); }
    float run = 0.f;
    if (dir == 0) {
#pragma unroll
        for (int u = 0; u < 16; ++u) { run += dtl[u] * A; cs[u] = run; }
    } else {
#pragma unroll
        for (int u = 15; u >= 0; --u) { run += dtl[u] * A; cs[u] = run; }
    }
    sTot[seg * 64 + col] = run;
    __syncthreads();
    float off = 0.f;
#pragma unroll
    for (int s = 0; s < 8; ++s) { const float v = sTot[s * 64 + col]; if (dir == 0 ? (s < seg) : (s > seg)) off += v; }
    const size_t o = (size_t)dir * dir_stride + (size_t)h * L + c * 128 + seg * 16;
#pragma unroll
    for (int q = 0; q < 4; ++q) { *(f32x4*)(dtv + o + 4 * q) = (f32x4){dtl[4 * q], dtl[4 * q + 1], dtl[4 * q + 2], dtl[4 * q + 3]};
        *(f32x4*)(acs + o + 4 * q) = (f32x4){cs[4 * q] + off, cs[4 * q + 1] + off, cs[4 * q + 2] + off, cs[4 * q + 3] + off}; }
    __syncthreads();
}
DI void pool_wave(LAS unsigned char* wl, const bf16_t* v, bf16_t* dd, int r, int gi, int cq, int lane) {
    LAS float* sV = (LAS float*)wl;
    const int k = 2 << gi, lo = k >> 1, hi = k - 1 - lo;
    const int c8 = lane & 7, wq = lane >> 3, ch = gi * 256 + cq * 64 + c8 * 8;
    const int r_lo = max(r - lo, 0), r_hi = min(r + hi + 1, 64);
    const float inv_r = 1.f / (float)(r_hi - r_lo);
    float acc[8][8]; u32x4 ctr[8];
#pragma unroll
    for (int q = 0; q < 8; ++q) { ctr[q] = (u32x4){0u, 0u, 0u, 0u};
#pragma unroll
        for (int e = 0; e < 8; ++e) acc[q][e] = 0.f; }
    for (int rr = r_lo; rr < r_hi; ++rr) { u32x4 x[8];
#pragma unroll
        for (int q = 0; q < 8; ++q) x[q] = *(const u32x4*)(v + ((size_t)(rr * 64 + wq * 8 + q) * 1024 + ch));
#pragma unroll
        for (int q = 0; q < 8; ++q) { float f[8]; unpack8(x[q], f);
#pragma unroll
            for (int e = 0; e < 8; ++e) acc[q][e] += f[e];
            if (rr == r) ctr[q] = x[q]; } }
#pragma unroll
    for (int q = 0; q < 8; ++q) { LAS float* p = sV + (wq * 8 + q) * 68 + c8 * 8;
        *(LAS f32x4*)p = (f32x4){acc[q][0] * inv_r, acc[q][1] * inv_r, acc[q][2] * inv_r, acc[q][3] * inv_r};
        *(LAS f32x4*)(p + 4) = (f32x4){acc[q][4] * inv_r, acc[q][5] * inv_r, acc[q][6] * inv_r, acc[q][7] * inv_r}; }
    asm volatile("s_waitcnt lgkmcnt(0)" ::: "memory");
    const int wb = wq * 8;
    f32x4 s0 = (f32x4){0.f, 0.f, 0.f, 0.f}, s1 = s0;
    for (int ww = max(wb - lo, 0); ww < min(wb + hi + 1, 64); ++ww) { const LAS float* p = sV + ww * 68 + c8 * 8; s0 += *(const LAS f32x4*)p; s1 += *(const LAS f32x4*)(p + 4); }
#pragma unroll
    for (int q = 0; q < 8; ++q) { const int w = wb + q, w_lo = max(w - lo, 0), w_hi = min(w + hi + 1, 64);
        const float inv_w = 1.f / (float)(w_hi - w_lo); float cv[8]; unpack8(ctr[q], cv); float o[8];
#pragma unroll
        for (int e = 0; e < 4; ++e) { o[e] = s0[e] * inv_w - cv[e]; o[4 + e] = s1[e] * inv_w - cv[4 + e]; }
        *(u32x4*)(dd + ((size_t)(r * 64 + w) * 1024 + ch)) = pack8(o);
        if (q < 7) { const int wa = w + 1 + hi, ws_ = w - lo;
            if (wa < 64) { const LAS float* p = sV + wa * 68 + c8 * 8; s0 += *(const LAS f32x4*)p; s1 += *(const LAS f32x4*)(p + 4); }
            if (ws_ >= 0) { const LAS float* p = sV + ws_ * 68 + c8 * 8; s0 -= *(const LAS f32x4*)p; s1 -= *(const LAS f32x4*)(p + 4); } } }
    asm volatile("s_waitcnt lgkmcnt(0)" ::: "memory");
}
DI void ssd_phase(LAS unsigned char* lds, const unsigned char* ws, const float* d_skip_p, int b0, int vcu, int G, int tid_in) {
    int tid_l = tid_in; asm volatile("" : "+v"(tid_l));
    const int tid = tid_l, wid = __builtin_amdgcn_readfirstlane(tid >> 6), lane = tid & 63, fr = lane & 15, fq = lane >> 4;
    constexpr int TILE = 64 * RS, OFF_HB = 2 * TILE, OFF_SC = 4 * TILE;
    const unsigned lb = (unsigned)(size_t)lds;
    unsigned a_frag = lb + fr * RS + fq * 16, a_f = lb + OFF_SC + fq * 32, a_xw = lb + (tid >> 3) * RS + (tid & 7) * 32, a_hw = lb + OFF_HB + fr * RS + wid * 32 + fq * 8, a_sw = lb + OFF_SC + tid * 4,
             a_ai = lb + OFF_SC + 512 + (wid * 16 + fr) * 4;
    asm volatile("" : "+v"(a_frag), "+v"(a_f), "+v"(a_xw), "+v"(a_hw), "+v"(a_sw), "+v"(a_ai));
    unsigned ln_bt = (wid * 16 + fr) * 256 + fq * 16, ln_cg = (wid * 16 + fr) * 1024 + fq * 16, ln_xt = tid * 32, ln_da = tid * 4, ln_y = (wid * 16 + fr) * 4096 + fq * 8;
    asm volatile("" : "+v"(ln_bt), "+v"(ln_cg), "+v"(ln_xt), "+v"(ln_da), "+v"(ln_y));
#define XTF(q, pb, ks) (*(const LAS bf16x8*)(a_frag + ((q) * TILE + (pb) * 16 * RS + (ks) * 64)))
#define HBF(q, pb, ks) (*(const LAS bf16x8*)(a_frag + (OFF_HB + (q) * TILE + (pb) * 16 * RS + (ks) * 64)))
#define SCV(q, arr, ks, half) (*(const LAS f32x4*)(a_f + ((q) * 1536 + (arr) * 512 + (ks) * 128 + (half) * 16)))
    for (int pair = vcu; pair < NB * 32; pair += G) {
        const int hh = pair & 7, g = (pair >> 3) & 3, bl = pair >> 5, h = g * 8 + hh, bg = b0 + bl;
        const float dsk = d_skip_p[h];
        f32x4 accH[2][4];
        u32x4 xt0[2], xt1[2]; bf16x8 bt[2][4], gt[2][4], cgf[2][4]; float r_dt[2], r_acs[2], r_alast[2];
#pragma unroll
        for (int q = 0; q < 2; ++q) { xt0[q] = (u32x4){0u, 0u, 0u, 0u}; xt1[q] = xt0[q]; r_dt[q] = 0.f; r_acs[q] = 0.f; r_alast[q] = 0.f;
#pragma unroll
            for (int k = 0; k < 4; ++k) { accH[q][k] = (f32x4){0.f, 0.f, 0.f, 0.f}; bt[q][k] = (bf16x8){0, 0, 0, 0, 0, 0, 0, 0}; gt[q][k] = bt[q][k]; cgf[q][k] = bt[q][k]; } }
#define UNI(v_) asm volatile("" : "+s"(v_))
#define SSD_LOAD_XT_DA(q, s_) do { const int s__ = (s_); unsigned xo, dof, aof; \
        if (s__ < 2) { const int cc = q == 0 ? s__ : 1 - s__; xo = (unsigned)WS_CXT + (unsigned)((bg * 2 + cc) * 2048 + h * 64) * 256u; const unsigned o = ((unsigned)((q * 16 + bg) * 32 + h) * 256u + cc * 128) * 4u; dof = (unsigned)WS_CDTV + o; aof = (unsigned)WS_CACS + o; } \
        else { const int c_ = q == 0 ? s__ - 2 : 33 - s__; xo = (unsigned)WS_XT + (unsigned)((bl * 32 + c_) * 2048 + h * 64) * 256u; const unsigned o = ((unsigned)((q * NB + bl) * 32 + h) * 4096u + c_ * 128) * 4u; dof = (unsigned)WS_DTV + o; aof = (unsigned)WS_ACS + o; } \
        UNI(xo); UNI(dof); UNI(aof); const unsigned char* xp = ws + xo; const unsigned char* dp = ws + dof; const unsigned char* ap = ws + aof; \
        xt0[q] = *(const u32x4*)(xp + ln_xt); xt1[q] = *(const u32x4*)(xp + ln_xt + 16); \
        if (tid < 128) { r_dt[q] = *(const float*)(dp + ln_da); r_acs[q] = *(const float*)(ap + ln_da); } r_alast[q] = *(const float*)(ap + (q == 0 ? 127 * 4 : 0)); } while (0)
#define SSD_LOAD_BT(q, s_) do { const int s__ = (s_); unsigned bo; \
        if (s__ < 2) { const int cc = q == 0 ? s__ : 1 - s__; bo = (unsigned)WS_CBT + (unsigned)((bg * 2 + cc) * 512 + g * 128) * 256u; } \
        else { const int c_ = q == 0 ? s__ - 2 : 33 - s__; bo = (unsigned)WS_BT + (unsigned)((bl * 32 + c_) * 512 + g * 128) * 256u; } \
        UNI(bo); const unsigned char* bp = ws + bo; \
        _Pragma("unroll") for (int ks = 0; ks < 4; ++ks) bt[q][ks] = *(const bf16x8*)(bp + ln_bt + ks * 64); } while (0)
#define SSD_LOAD_GT_CG(q, s_) do { const int c_ = q == 0 ? (s_) - 2 : 33 - (s_); \
        unsigned go = (unsigned)WS_GT + (unsigned)(((bl * 32 + c_) * 4 + g) * 128) * 256u, co = (unsigned)WS_CG + (unsigned)(bl * 4096 + c_ * 128) * 1024u + g * 256; \
        UNI(go); UNI(co); const unsigned char* gp = ws + go; const unsigned char* cp_ = ws + co; \
        _Pragma("unroll") for (int ks = 0; ks < 4; ++ks) { gt[q][ks] = *(const bf16x8*)(gp + ln_bt + ks * 64); cgf[q][ks] = *(const bf16x8*)(cp_ + ln_cg + ks * 64); } } while (0)
        SSD_LOAD_XT_DA(0, 0); SSD_LOAD_XT_DA(1, 0); SSD_LOAD_BT(0, 0); SSD_LOAD_BT(1, 0);
        for (int s = 0; s < 34; ++s) {
            float alast[2];
#pragma unroll
            for (int q = 0; q < 2; ++q) {
                *(LAS u32x4*)(a_xw + q * TILE) = xt0[q]; *(LAS u32x4*)(a_xw + (q * TILE + 16)) = xt1[q];
#pragma unroll
                for (int pb = 0; pb < 4; ++pb) { u32x2 pk; pk.x = cvt_pk_bf16(accH[q][pb][0], accH[q][pb][1]); pk.y = cvt_pk_bf16(accH[q][pb][2], accH[q][pb][3]);
                    *(LAS u32x2*)(a_hw + (q * TILE + pb * 16 * RS)) = pk; }
                alast[q] = r_alast[q];
                if (tid < 128) { *(LAS float*)(a_sw + q * 1536) = r_dt[q]; *(LAS float*)(a_sw + (q * 1536 + 512)) = r_acs[q]; *(LAS float*)(a_sw + (q * 1536 + 1024)) = r_dt[q] * __expf(alast[q] - r_acs[q]); }
            }
            __syncthreads();
            if (s + 1 < 34) { SSD_LOAD_XT_DA(0, s + 1); SSD_LOAD_XT_DA(1, s + 1); }
            if (s >= 2) {
#pragma unroll
              for (int q = 0; q < 2; ++q) {
                const int c_ = q == 0 ? s - 2 : 33 - s;
                f32x4 accD[4];
#pragma unroll
                for (int pb = 0; pb < 4; ++pb) accD[pb] = (f32x4){0.f, 0.f, 0.f, 0.f};
                int i_l = wid * 16 + fr; asm volatile("" : "+v"(i_l)); const int i = i_l;
                const float acs_i = *(const LAS float*)(a_ai + q * 1536);
                const float ei = __expf(acs_i);
#pragma unroll
                for (int ks = 0; ks < 4; ++ks) { float cv[8]; unpack8(__builtin_bit_cast(u32x4, cgf[q][ks]), cv);
#pragma unroll
                    for (int e = 0; e < 8; ++e) cv[e] *= ei;
                    const bf16x8 cs = __builtin_bit_cast(bf16x8, pack8(cv));
#pragma unroll
                    for (int pb = 0; pb < 4; ++pb) { const bf16x8 a = HBF(q, pb, ks); accD[pb] = MFMA16(a, cs, accD[pb]); } }
#pragma unroll
                for (int ks = 0; ks < 4; ++ks) {
                    const bool need = q == 0 ? (ks <= (wid >> 1)) : (ks >= (wid >> 1));
                    if (need) {
                        const int j0 = ks * 32 + fq * 8;
                        const f32x4 a0 = SCV(q, 1, ks, 0), a1 = SCV(q, 1, ks, 1), d0 = SCV(q, 0, ks, 0), d1 = SCV(q, 0, ks, 1);
                        float gv[8]; unpack8(__builtin_bit_cast(u32x4, gt[q][ks]), gv); float mv[8];
#pragma unroll
                        for (int e = 0; e < 8; ++e) { const int j = j0 + e; const float aj = e < 4 ? a0[e & 3] : a1[e & 3], dj = e < 4 ? d0[e & 3] : d1[e & 3];
                            const bool valid = q == 0 ? (j <= i) : (j >= i);
                            float val = gv[e] * __expf(acs_i - aj) * dj; if (q == 0 && j == i) val += dsk;
                            mv[e] = valid ? val : 0.f; }
                        const bf16x8 mf = __builtin_bit_cast(bf16x8, pack8(mv));
#pragma unroll
                        for (int pb = 0; pb < 4; ++pb) { const bf16x8 a = XTF(q, pb, ks); accD[pb] = MFMA16(a, mf, accD[pb]); }
                    }
                }
                unsigned yo = (unsigned)(q == 0 ? WS_YF : WS_YB) + ((unsigned)(bl * 4096 + c_ * 128) * 2048u + h * 64) * 2u; UNI(yo);
                unsigned char* yrow = (unsigned char*)ws + yo + ln_y;
#pragma unroll
                for (int pb = 0; pb < 4; ++pb) { u32x2 pk; pk.x = cvt_pk_bf16(accD[pb][0], accD[pb][1]); pk.y = cvt_pk_bf16(accD[pb][2], accD[pb][3]);
                    *(u32x2*)(yrow + pb * 32) = pk; }
                if (s + 1 < 34) SSD_LOAD_GT_CG(q, s + 1);
              }
            } else if (s + 1 >= 2) { SSD_LOAD_GT_CG(0, s + 1); SSD_LOAD_GT_CG(1, s + 1); }
#pragma unroll
            for (int q = 0; q < 2; ++q) {
                const float dec = __expf(alast[q]);
#pragma unroll
                for (int pb = 0; pb < 4; ++pb) accH[q][pb] *= dec;
#pragma unroll
                for (int ks = 0; ks < 4; ++ks) {
                    const f32x4 w0 = SCV(q, 2, ks, 0), w1 = SCV(q, 2, ks, 1);
                    float bv[8]; unpack8(__builtin_bit_cast(u32x4, bt[q][ks]), bv);
#pragma unroll
                    for (int e = 0; e < 4; ++e) { bv[e] *= w0[e]; bv[4 + e] *= w1[e]; }
                    const bf16x8 bw = __builtin_bit_cast(bf16x8, pack8(bv));
#pragma unroll
                    for (int pb = 0; pb < 4; ++pb) { const bf16x8 xf = XTF(q, pb, ks); accH[q][pb] = MFMA16(bw, xf, accH[q][pb]); } }
                if (s + 1 < 34) SSD_LOAD_BT(q, s + 1);
            }
            __syncthreads();
        }
#undef SSD_LOAD_XT_DA
#undef SSD_LOAD_BT
#undef SSD_LOAD_GT_CG
#undef UNI
#undef XTF
#undef HBF
#undef SCV
    }
}

#define RLX_AGENT __ATOMIC_RELAXED, __HIP_MEMORY_SCOPE_AGENT
#define XB_TMO      128
#define XB_XCNT(j)  (256  + 64 * (j))
#define XB_XSUB(j)  (1280 + 64 * (j))
#define XB_XGEN(j)  (2304 + 64 * (j))
#define XB_TOP      3328
#define XB_TOPGEN   3392
#define XCD_BAR_WORDS 3456
#define XB_SPIN_CAP (1u << 18)

__device__ __forceinline__ unsigned xb_ld(unsigned* p)              { return __hip_atomic_load(p, __ATOMIC_RELAXED, __HIP_MEMORY_SCOPE_AGENT); }
__device__ __forceinline__ unsigned xb_add(unsigned* p, unsigned v) { return __hip_atomic_fetch_add(p, v, __ATOMIC_RELAXED, __HIP_MEMORY_SCOPE_AGENT); }
__device__ __forceinline__ unsigned xb_xcc_id() { return (unsigned)__builtin_amdgcn_s_getreg((3 << 11) | 20) & 0xFu; }
#define XB_SPIN(cond, bar) do { unsigned _sp = 0; while (cond) { __builtin_amdgcn_s_sleep(1); \
    if ((++_sp & 255u) == 0u) { if (xb_ld(&(bar)[XB_TMO])) break; if (_sp > XB_SPIN_CAP) { atomicAdd(&(bar)[XB_TMO], 1u); break; } } } } while (0)

struct XcdBarrier {
    unsigned* bar; unsigned x;
    volatile LAS unsigned* st;
};

__device__ __forceinline__ XcdBarrier xcd_barrier_post(unsigned* bar, volatile LAS unsigned* st) {
    XcdBarrier b; b.bar = bar; b.x = xb_xcc_id(); b.st = st;
    if (threadIdx.x == 0) (void)xb_add(&bar[XB_XCNT(b.x)], 1u);
    return b;
}
__device__ __forceinline__ void xcd_barrier_complete(unsigned* bar, unsigned x, unsigned& nloc, unsigned& nx) {
    const unsigned G = gridDim.x * gridDim.y * gridDim.z;
    unsigned sum, cnt, mine, sp = 0u;
    for (;;) {
        sum = 0u; cnt = 0u; mine = 0u;
#pragma unroll
        for (unsigned j = 0; j < 16; ++j) { const unsigned c = xb_ld(&bar[XB_XCNT(j)]); sum += c; cnt += (c > 0u) ? 1u : 0u; mine = (j == x) ? c : mine; }
        if (sum == G) break;
        __builtin_amdgcn_s_sleep(1);
        if ((++sp & 255u) == 0u) { if (xb_ld(&bar[XB_TMO])) break; if (sp > XB_SPIN_CAP) { atomicAdd(&bar[XB_TMO], 1u); break; } }
    }
    nloc = mine > 0u ? mine : 1u; nx = cnt > 0u ? cnt : 1u;
}

__device__ __forceinline__ void xcd_barrier(const XcdBarrier& b, bool leader) {
    asm volatile("s_waitcnt vmcnt(0)" ::: "memory");
    __syncthreads();
    if (leader) {
        unsigned* bar = b.bar;
        __builtin_amdgcn_s_waitcnt(0);
        unsigned nloc = b.st[0], nx = b.st[1];
        if (nloc == 0u) { xcd_barrier_complete(bar, b.x, nloc, nx); b.st[0] = nloc; b.st[1] = nx; }
        const unsigned old = xb_add(&bar[XB_XSUB(b.x)], 1u);
        const unsigned gen = old / nloc;
        if (old + 1u == (gen + 1u) * nloc) {
            __builtin_amdgcn_fence(__ATOMIC_RELEASE, "agent");
            asm volatile("s_waitcnt vmcnt(0)" ::: "memory");
            const unsigned og = xb_add(&bar[XB_TOP], 1u);
            const unsigned tg = og / nx;
            if (og + 1u == (tg + 1u) * nx) xb_add(&bar[XB_TOPGEN], 1u);
            else XB_SPIN(xb_ld(&bar[XB_TOPGEN]) == tg, bar);
            __builtin_amdgcn_fence(__ATOMIC_ACQUIRE, "agent");
            xb_add(&bar[XB_XGEN(b.x)], 1u);
            asm volatile("s_waitcnt vmcnt(0)" ::: "memory");
        } else {
            XB_SPIN(xb_ld(&bar[XB_XGEN(b.x)]) == gen, bar);
            __builtin_amdgcn_fence(__ATOMIC_ACQUIRE, "agent");
            asm volatile("s_waitcnt vmcnt(0)" ::: "memory");
        }
    }
    __syncthreads();
}

struct Args { const float* in[21]; float* out; unsigned char* ws; int ph_lo, ph_hi; };
static_assert(sizeof(Args) == 23 * 8 + 8, "Args has no padding");


#define IN_(k) (args.in[k])
#define x_in IN_(0)
#define c_in IN_(1)
#define ctx IN_(2)
#define c_ctx IN_(3)
#define w_ada IN_(4)
#define b_ada IN_(5)
#define norm_pre IN_(6)
#define norm_post IN_(7)
#define w_in IN_(8)
#define b_merge IN_(9)
#define pool_w IN_(10)
#define pool_scale IN_(11)
#define conv_w IN_(12)
#define conv_b IN_(13)
#define dt_bias IN_(14)
#define a_log IN_(15)
#define d_skip IN_(16)
#define ssd_norm IN_(17)
#define w_proj_pool IN_(18)
#define w_proj_ssd IN_(19)
#define w_out IN_(20)
#define out_p (args.out)
#define WSB(off) ((bf16_t*)(ws_l + (off)))
#define WSF(off) ((float*)(ws_l + (off)))
#define WIN WSB(WS_WIN)
#define WPP WSB(WS_WPP)
#define WPS WSB(WS_WPS)
#define WO WSB(WS_WO)
#define PW WSB(WS_PW)
#define MOD WSF(WS_MOD)
#define HC WSB(WS_HC)
#define CXBC WSB(WS_CXBC)
#define CXT WSB(WS_CXT)
#define CBT WSB(WS_CBT)
#define CDT WSF(WS_CDT)
#define CDTV WSF(WS_CDTV)
#define CACS WSF(WS_CACS)
#define HX WSB(WS_HX)
#define V WSB(WS_V)
#define SZS WSB(WS_SZS)
#define GATES WSB(WS_GATES)
#define XBC WSB(WS_XBC)
#define DTR WSF(WS_DTR)
#define DTV WSF(WS_DTV)
#define ACS WSF(WS_ACS)
#define XT WSB(WS_XT)
#define CG WSB(WS_CG)
#define BT WSB(WS_BT)
#define GT WSB(WS_GT)
#define YF WSB(WS_YF)
#define YP WSB(WS_YP)
#define YB WSB(WS_YB)
#define MRG WSB(WS_MRG)
__global__ void __launch_bounds__(NTHR, 2) fwd_megakernel(Args args) {
    extern __shared__ __attribute__((aligned(16))) unsigned char lds_raw[];
    cg::grid_group grid = cg::this_grid();
    LAS unsigned char* lds = (LAS unsigned char*)lds_raw;
    grid.sync();
    { volatile LAS unsigned* st0 = (volatile LAS unsigned*)(lds + LDS_BYTES - 64); if (threadIdx.x < 16) st0[threadIdx.x] = 0u; }
    __syncthreads();
    const XcdBarrier bar = xcd_barrier_post((unsigned*)(args.ws + WS_BAR), (volatile LAS unsigned*)(lds + LDS_BYTES - 64));
    const int G = gridDim.x, bx = blockIdx.x, NGW = G * 8, wave_k = __builtin_amdgcn_readfirstlane((int)threadIdx.x >> 6);
    const int lo = args.ph_lo, hi = args.ph_hi;
    int ph = 0;
#ifndef PROBE_MASK
#define PROBE_MASK 0
#endif
#define PHASE_BEGIN(id_) if (lo <= ph && ph < hi) { for (int rep_ = 0; rep_ <= ((PROBE_MASK >> (id_)) & 1); ++rep_) { int tid_l = wave_k * 64 + fresh_lane(); asm volatile("" : "+v"(tid_l)); const int tid = tid_l, lane = tid & 63, wave = wave_k; \
        int vcu_l = (G % 8 == 0) ? (bx % 8) * (G / 8) + bx / 8 : bx; asm volatile("" : "+s"(vcu_l)); const int vcu = vcu_l, gw = vcu * 8 + wave; (void)tid; (void)lane; (void)gw; \
        unsigned char* ws_l = args.ws; asm volatile("" : "+s"(ws_l));
#define PHASE_END } } ++ph; if (lo < ph && ph < hi) xcd_barrier(bar, wave_k == 0 && fresh_lane() == 0);

    PHASE_BEGIN(0)
        for (int it = vcu; it < 48; it += G) mod_item(lds, c_in, c_ctx, w_ada, b_ada, MOD, it, tid);
        LAS float* scr = (LAS float*)(lds + wave * 16384);
        constexpr int I_IN = 16 * 290, I_PP = 16 * 32, I_PS = 32 * 32, I_O = 16 * 32, I_PW = 4 * 8;
        for (int it = gw; it < I_IN + I_PP + I_PS + I_O + 4 * I_PW; it += NGW) {
            int r = it;
            if (r < I_IN) { transpose_item(w_in, 1024, 9280, WIN, 1024, 0, scr, r, lane); continue; } r -= I_IN;
            if (r < I_PP) { transpose_item(w_proj_pool, 1024, 1024, WPP, 1024, 0, scr, r, lane); continue; } r -= I_PP;
            if (r < I_PS) { transpose_item(w_proj_ssd, 2048, 1024, WPS, 2048, 0, scr, r, lane); continue; } r -= I_PS;
            if (r < I_O) { transpose_item(w_out, 1024, 1024, WO, 1024, 0, scr, r, lane); continue; } r -= I_O;
            { const int gq = r / I_PW; transpose_item(pool_w + (size_t)gq * 65536, 256, 256, PW, 256, gq * 256, scr, r % I_PW, lane); }
        }
    PHASE_END
    PHASE_BEGIN(1)
        for (int m = gw; m < CT; m += NGW) modnorm_row(ctx + (size_t)m * 1024, norm_pre, MOD + 16 * 3072, HC + (size_t)m * 1024, lane);
        for (int m = gw; m < T; m += NGW) modnorm_row(x_in + (size_t)m * 1024, norm_pre, MOD + (m >> 12) * 3072, HX + (size_t)m * 1024, lane);
    PHASE_END
    for (int grp = 0; grp < NGRP; ++grp) {
        const int b0 = grp * NB; const size_t tok0 = (size_t)b0 * SEQ;
        float* outg = out_p + tok0 * 1024;
        bf16_t* SZP = (bf16_t*)outg; bf16_t* DD = (bf16_t*)outg + (size_t)T * 1024;
        PHASE_BEGIN(2)
            if (grp == 0) {
                pg8::Gemm g{HC, WIN + (size_t)24 * 256 * 1024, 1024, 1024, 1024, 0}; pg8::StaticOrder S; S.init(CT, 13 * 256, G, bx);
                EpiInProj E{nullptr, nullptr, nullptr, nullptr, CXBC, CDT, b_merge, 24};
                pg8::gemm_phase<EpiInProj, pg8::StaticOrder, true, true>(lds, g, S, E, tid);
            }
            { pg8::Gemm g{HX, WIN, 1024, 1024, 1024, 0}; pg8::StaticOrder S; S.init(T, INP, G, bx);
              EpiInProj E{V, SZP, SZS, GATES, XBC, DTR, b_merge, 0};
              pg8::gemm_phase<EpiInProj, pg8::StaticOrder, true, true>(lds, g, S, E, tid); }
        PHASE_END
        PHASE_BEGIN(3)
            if (grp == 0) {
                for (int it = vcu; it < 16 * 2 * 4; it += G) { const int g = it & 3, cc = (it >> 2) & 1, b = it >> 3;
                    conv_bc_item(lds, CXBC + (size_t)b * CTXL * 3072, CTXL, cc, g, CBT + ((size_t)((b * 2 + cc) * 512 + g * 128)) * 128, nullptr, nullptr, conv_w, conv_b, tid); }
                for (int it = vcu; it < 16 * 2; it += G) { const int cc = it & 1, b = it >> 1;
                    dt_item(lds, CDT + (size_t)b * CTXL * 64, CTXL, cc, CDTV + (size_t)b * 32 * CTXL, CACS + (size_t)b * 32 * CTXL, (size_t)16 * 32 * CTXL, dt_bias, a_log, tid); }
            }
            for (int it = vcu; it < NB * 32 * 4; it += G) { const int g = it & 3, cc = (it >> 2) & 31, b = it >> 7;
                conv_bc_item(lds, XBC + (size_t)b * SEQ * 3072, SEQ, cc, g, BT + ((size_t)((b * 32 + cc) * 512 + g * 128)) * 128, CG + ((size_t)(b * SEQ + cc * 128)) * 512 + g * 128,
                             GT + ((size_t)(((b * 32 + cc) * 4 + g) * 128)) * 128, conv_w, conv_b, tid); }
            for (int it = vcu; it < NB * 32; it += G) { const int cc = it & 31, b = it >> 5;
                dt_item(lds, DTR + (size_t)b * SEQ * 64, SEQ, cc, DTV + (size_t)b * 32 * SEQ, ACS + (size_t)b * 32 * SEQ, (size_t)NB * 32 * SEQ, dt_bias, a_log, tid); }
            { LAS unsigned char* wl = lds + wave * (64 * RS);
              if (grp == 0) for (int it = gw; it < 16 * 2 * 32; it += NGW) { const int hb = it & 31, cc = (it >> 5) & 1, b = it >> 6;
                    conv_xs_wave(wl, CXBC + (size_t)b * CTXL * 3072, CTXL, cc, hb, CXT + ((size_t)((b * 2 + cc) * 2048 + hb * 64)) * 128, conv_w, conv_b, lane); }
              for (int it = gw; it < NB * 32 * 32; it += NGW) { const int hb = it & 31, cc = (it >> 5) & 31, b = it >> 10;
                    conv_xs_wave(wl, XBC + (size_t)b * SEQ * 3072, SEQ, cc, hb, XT + ((size_t)((b * 32 + cc) * 2048 + hb * 64)) * 128, conv_w, conv_b, lane); }
              for (int it = gw; it < NB * 64 * 16; it += NGW) { const int cq = it & 3, gi = (it >> 2) & 3, r = (it >> 4) & 63, b = it >> 10;
                    pool_wave(wl, V + (size_t)b * SEQ * 1024, DD + (size_t)b * SEQ * 1024, r, gi, cq, lane); } }
        PHASE_END
        PHASE_BEGIN(4)
            ssd_phase(lds, ws_l, d_skip, b0, vcu, G, tid);
        PHASE_END
        PHASE_BEGIN(5)
            for (int it = gw; it < T * 4; it += NGW) { const int gq = it & 3; const size_t m = (size_t)(it >> 2);
                gnorm_item(YF + m * 2048 + gq * 512, YB + m * 2048 + gq * 512, SZS + m * 2048 + gq * 512, ssd_norm + gq * 512, lane); }
            asm volatile("s_waitcnt vmcnt(0)" ::: "memory"); __syncthreads();
            { pg8::Gemm g{DD, PW, 1024, 256, 256, 256}; pg8::StaticOrder S; S.init(T, 1024, G, bx);
              EpiPool E{YP, SZP, pool_scale};
              pg8::gemm_phase<EpiPool, pg8::StaticOrder, true, true>(lds, g, S, E, tid); }
        PHASE_END
        PHASE_BEGIN(6)
            { pg8::Gemm g{YP, WPP, 1024, 1024, 1024, 0}; pg8::StaticOrder S; S.init(T, 1024, G, bx);
              EpiM1 E{outg, GATES};
              pg8::gemm_phase<EpiM1, pg8::StaticOrder, true, true>(lds, g, S, E, tid); }
            asm volatile("s_waitcnt vmcnt(0)" ::: "memory"); __syncthreads();
            { pg8::Gemm g{YF, WPS, 2048, 2048, 2048, 0}; pg8::StaticOrder S; S.init(T, 1024, G, bx);
              EpiM2 E{outg, GATES, MRG};
              pg8::gemm_phase<EpiM2, pg8::StaticOrder, true, true>(lds, g, S, E, tid); }
        PHASE_END
        PHASE_BEGIN(7)
            { pg8::Gemm g{MRG, WO, 1024, 1024, 1024, 0}; pg8::StaticOrder S; S.init(T, 1024, G, bx);
              EpiF32 E{outg};
              pg8::gemm_phase<EpiF32, pg8::StaticOrder, true, true>(lds, g, S, E, tid); }
        PHASE_END
        PHASE_BEGIN(8)
            for (int m = gw; m < T; m += NGW) { const size_t row = tok0 + m; final_row(out_p + row * 1024, x_in + row * 1024, norm_post, MOD + (row >> 12) * 3072 + 2048, lane); }
            if (grp + 1 < NGRP) for (int m = gw; m < T; m += NGW) { const size_t row = tok0 + T + m; modnorm_row(x_in + row * 1024, norm_pre, MOD + (row >> 12) * 3072, HX + (size_t)m * 1024, lane); }
        PHASE_END
    }
#undef PHASE_BEGIN
#undef PHASE_END
}

#undef x_in
#undef c_in
#undef ctx
#undef c_ctx
#undef w_ada
#undef b_ada
#undef norm_pre
#undef norm_post
#undef w_in
#undef b_merge
#undef pool_w
#undef pool_scale
#undef conv_w
#undef conv_b
#undef dt_bias
#undef a_log
#undef d_skip
#undef ssd_norm
#undef w_proj_pool
#undef w_proj_ssd
#undef w_out
#undef out_p
#undef WIN
#undef WPP
#undef WPS
#undef WO
#undef PW
#undef MOD
#undef HC
#undef CXBC
#undef CXT
#undef CBT
#undef CDT
#undef CDTV
#undef CACS
#undef HX
#undef V
#undef SZS
#undef GATES
#undef XBC
#undef DTR
#undef DTV
#undef ACS
#undef XT
#undef CG
#undef BT
#undef GT
#undef YF
#undef YP
#undef YB
#undef MRG
extern "C" void kernel_launch(void* const* d_in, const int* in_sizes, int n_in, void* d_out, int out_size, void* d_ws, size_t ws_size, hipStream_t stream) {
    static int grid = 0;
    if (grid == 0) {
        int dev = 0, cus = 0, per_cu = 0;
        (void)hipGetDevice(&dev); (void)hipDeviceGetAttribute(&cus, hipDeviceAttributeMultiprocessorCount, dev);
        (void)hipFuncSetAttribute((const void*)fwd_megakernel, hipFuncAttributeMaxDynamicSharedMemorySize, LDS_BYTES);
        (void)hipOccupancyMaxActiveBlocksPerMultiprocessor(&per_cu, (const void*)fwd_megakernel, NTHR, LDS_BYTES);
        if (per_cu < 1) per_cu = 1;
        grid = cus * per_cu;
        if (n_in != 21 || ws_size < WS_END) { fprintf(stderr, "kernel_launch: unexpected n_in %d / ws %zu\n", n_in, ws_size); }
        (void)hipGetLastError();
    }
    (void)hipMemsetAsync((char*)d_ws + WS_BAR, 0, 16384, stream);
    Args a{};
    for (int i = 0; i < 21; ++i) a.in[i] = (const float*)d_in[i];
    a.out = (float*)d_out; a.ws = (unsigned char*)d_ws; a.ph_lo = 0; a.ph_hi = 1 << 20;
    void* kargs[] = {&a};
    hipError_t e = hipLaunchCooperativeKernel((const void*)fwd_megakernel, dim3(grid), dim3(NTHR), kargs, LDS_BYTES, stream);
    if (e != hipSuccess) fprintf(stderr, "cooperative launch failed: %s (grid %d)\n", hipGetErrorString(e), grid);
}
```

```cpp
#include <hip/hip_runtime.h>
#include <hip/hip_cooperative_groups.h>
#include <cstdio>
#include <cstdint>
namespace cg = cooperative_groups;
namespace pg8 {
#define PG8_LAS __attribute__((address_space(3)))
typedef unsigned short bf16_t;
typedef short bf16x8 __attribute__((ext_vector_type(8)));
typedef float f32x4 __attribute__((ext_vector_type(4)));
typedef unsigned u32x4 __attribute__((ext_vector_type(4)));
constexpr int BM = 256, BK = 64, HALF = 128, HTB = HALF * BK * 2  , STAGE_BYTES = 8 * HTB, NXCD = 8, WGM = 8;

__host__ __device__ __forceinline__ int lds_byte(int r, int c) { const int st = (r >> 4) * 2 + (c >> 5), rr = r & 15, cc = c & 31, ob = rr * 64 + cc * 2; return st * 1024 + (ob ^ (((ob >> 9) & 1) << 5)); }
__host__ __device__ __forceinline__ void stage_rc(int b, int& R, int& C) { const int st = b / 1024, sb = b % 1024, swz = sb ^ (((sb >> 9) & 1) << 5); R = (st >> 1) * 16 + swz / 64; C = (st & 1) * 32 + (swz % 64) / 2; }
__host__ __device__ __forceinline__ int perm32(int rho) { const int n = rho >> 4, i = rho & 15; return 8 * (i >> 2) + 4 * n + (i & 3); }

struct Unit { int pm, pn; };
struct Gemm { const bf16_t* A; const bf16_t* Bt; int lda, ldb, K, a_pn_off; };
struct StaticOrder {
    int nM, nN, nwg, G, c;
    __host__ __device__ void init(int M, int N, int G_, int c_) { nM = M / BM; nN = N / BM; nwg = nM * nN; G = G_; c = c_; }
    __host__ __device__ bool next(int i, Unit& u) const {
        const long L = (long)i * G + c; if (L >= nwg) return false;
        int wgid = (int)L; { const int q = nwg / NXCD, r = nwg % NXCD, xcd = wgid % NXCD, off = wgid / NXCD; wgid = (xcd < r ? xcd * (q + 1) : r * (q + 1) + (xcd - r) * q) + off; }
        const int nig = WGM * nN, gid = wgid / nig, fm = gid * WGM, gsz = (nM - fm) < WGM ? (nM - fm) : WGM;
        u.pm = fm + ((wgid % nig) % gsz); u.pn = (wgid % nig) / gsz; return true;
    }
    __device__ __forceinline__ void a_ready(const Unit&) const {}
    __device__ __forceinline__ void done(const Unit&) const {}
};
typedef float f32x2_cv __attribute__((ext_vector_type(2)));
typedef __bf16 bf16x2_cv __attribute__((ext_vector_type(2)));
__device__ __forceinline__ unsigned cvt_pk_bf16(float lo, float hi) { const f32x2_cv v = {lo, hi}; const bf16x2_cv b = __builtin_convertvector(v, bf16x2_cv); return __builtin_bit_cast(unsigned, b); }
template <class Epi, class Sched, bool ALIGN_EPI = false, bool SP2 = false>
__device__ __forceinline__ void gemm_phase(PG8_LAS unsigned char* lds, const Gemm g, const Sched& S, const Epi& E, int tid_in) {
    int tid_l = tid_in; asm volatile("" : "+v"(tid_l));
    const int tid = tid_l, wid = __builtin_amdgcn_readfirstlane(tid >> 6), lane = tid & 63, wr = wid >> 2, wc = wid & 3, fr = lane & 15, fq = lane >> 4;
    const int K = g.K, nt = K / BK;
    unsigned voffA[2], voffB[2];
#pragma unroll
    for (int i = 0; i < 2; ++i) { int R, C; stage_rc(tid * 16 + i * 8192, R, C); const int Rb = Epi::PERM ? ((R & ~31) + perm32(R & 31)) : R;
        voffA[i] = (unsigned)(R * g.lda + C) * 2u; voffB[i] = (unsigned)(Rb * g.ldb + C) * 2u; }
    const size_t kstep = (size_t)(BK * 2);
    const size_t hstepA = (size_t)HALF * g.lda * 2, hstepB = (size_t)HALF * g.ldb * 2;
    const size_t tstepA = 2 * hstepA, tstepB = 2 * hstepB, pnoffA = (size_t)g.a_pn_off * 2;
    const unsigned ldsw = (unsigned)wid * 1024u;
    const int aoff = lds_byte(wr * 64 + fr, fq * 8), boff = lds_byte(wc * 32 + fr, fq * 8);
#define PG8_SA(b, h) (((b) * 2 + (h)) * HTB)
#define PG8_SB(b, h) ((4 + (b) * 2 + (h)) * HTB)
#define PG8_STAGE(bufoff, gbase, voff) do { _Pragma("unroll") for (int _i = 0; _i < 2; ++_i) \
        __builtin_amdgcn_global_load_lds((const unsigned*)((const char*)(gbase) + (voff)[_i]), (PG8_LAS unsigned*)(lds + (bufoff) + ldsw + _i * 8192), 16, 0, 0); } while (0)
#define PG8_LDA(dst, b, h) do { _Pragma("unroll") for (int m = 0; m < 4; ++m) _Pragma("unroll") for (int k = 0; k < 2; ++k) dst[m][k] = *(const PG8_LAS bf16x8*)(lds + PG8_SA(b, h) + aoff + m * 2048 + k * 1024); } while (0)
#define PG8_LDB(dst, b, h) do { _Pragma("unroll") for (int n = 0; n < 2; ++n) _Pragma("unroll") for (int k = 0; k < 2; ++k) dst[n][k] = *(const PG8_LAS bf16x8*)(lds + PG8_SB(b, h) + boff + n * 2048 + k * 1024); } while (0)
#define PG8_MMA(ai, bj, At, Bt) do { __builtin_amdgcn_s_setprio(1); _Pragma("unroll") for (int m = 0; m < 4; ++m) _Pragma("unroll") for (int n = 0; n < 2; ++n) _Pragma("unroll") for (int k = 0; k < 2; ++k) \
        acc[ai][bj][m][n] = __builtin_amdgcn_mfma_f32_16x16x32_bf16(Bt[n][k], At[m][k], acc[ai][bj][m][n], 0, 0, 0); __builtin_amdgcn_s_setprio(0); } while (0)
#define PG8_WAIT_V(n) asm volatile("s_waitcnt vmcnt(" #n ")" ::: "memory")
#define PG8_WAIT_L(n) asm volatile("s_waitcnt lgkmcnt(" #n ")" ::: "memory")
#define PG8_BAR __builtin_amdgcn_s_barrier()
#define PG8_SCHED __builtin_amdgcn_sched_barrier(0)
    Unit cur, nxt; int ui = 0;
    if (!S.next(0, cur)) return;
    f32x4 acc[2][2][4][2];
#pragma unroll
    for (int a = 0; a < 2; ++a)
#pragma unroll
        for (int b = 0; b < 2; ++b)
#pragma unroll
            for (int m = 0; m < 4; ++m)
#pragma unroll
                for (int n = 0; n < 2; ++n) acc[a][b][m][n] = (f32x4){0.f, 0.f, 0.f, 0.f};
    bf16x8 At[4][2], B0[2][2], B1[2][2];
    const char* cA = (const char*)g.A + (size_t)cur.pm * tstepA + (size_t)cur.pn * pnoffA; const char* cB = (const char*)g.Bt + (size_t)cur.pn * tstepB;
    S.a_ready(cur);
    if constexpr (SP2) {
        PG8_STAGE(PG8_SB(0, 0), cB, voffB); PG8_STAGE(PG8_SB(0, 1), cB + hstepB, voffB); PG8_STAGE(PG8_SA(0, 0), cA, voffA); PG8_STAGE(PG8_SA(0, 1), cA + hstepA, voffA);
        if (wr == 1) PG8_BAR;
        PG8_WAIT_V(2); PG8_BAR;
        PG8_STAGE(PG8_SB(1, 0), cB + kstep, voffB); PG8_STAGE(PG8_SA(1, 0), cA + kstep, voffA); PG8_STAGE(PG8_SB(1, 1), cB + hstepB + kstep, voffB);
        PG8_WAIT_V(6); PG8_BAR;
    } else {
        PG8_STAGE(PG8_SB(0, 0), cB, voffB); PG8_STAGE(PG8_SA(0, 0), cA, voffA); PG8_STAGE(PG8_SB(0, 1), cB + hstepB, voffB); PG8_STAGE(PG8_SA(0, 1), cA + hstepA, voffA);
        if (wr == 1) PG8_BAR;
        PG8_WAIT_V(4); PG8_BAR;
        PG8_STAGE(PG8_SB(1, 0), cB + kstep, voffB); PG8_STAGE(PG8_SA(1, 0), cA + kstep, voffA); PG8_STAGE(PG8_SB(1, 1), cB + hstepB + kstep, voffB);
        PG8_WAIT_V(6); PG8_BAR;
    }
    for (;;) {
        const bool has_next = S.next(ui + 1, nxt);
        const char* nA = has_next ? (const char*)g.A + (size_t)nxt.pm * tstepA + (size_t)nxt.pn * pnoffA : cA; const char* nB = has_next ? (const char*)g.Bt + (size_t)nxt.pn * tstepB : cB;
        for (int t = 0; t < nt; t += 2) {
            const bool last = (t == nt - 2);
            const char* a1 = cA + (size_t)(t + 1) * kstep;
            const char* a2 = last ? nA : cA + (size_t)(t + 2) * kstep; const char* b2 = last ? nB : cB + (size_t)(t + 2) * kstep;
            const char* a3 = a2 + kstep; const char* b3 = b2 + kstep;
            if (last && has_next) S.a_ready(nxt);
            if constexpr (SP2) {
            PG8_LDB(B0, 0, 0); PG8_LDB(B1, 0, 1); PG8_SCHED; PG8_LDA(At, 0, 0); PG8_STAGE(PG8_SA(1, 1), a1 + hstepA, voffA);
            PG8_WAIT_V(8); PG8_WAIT_L(0); PG8_BAR; PG8_MMA(0, 0, At, B0); PG8_MMA(0, 1, At, B1); PG8_BAR; PG8_SCHED;
            PG8_LDA(At, 0, 1); PG8_STAGE(PG8_SB(0, 0), b2, voffB); PG8_STAGE(PG8_SB(0, 1), b2 + hstepB, voffB); PG8_STAGE(PG8_SA(0, 0), a2, voffA);
            PG8_WAIT_V(8); PG8_WAIT_L(0); PG8_BAR; PG8_MMA(1, 0, At, B0); PG8_MMA(1, 1, At, B1); PG8_BAR; PG8_SCHED;
            PG8_LDB(B0, 1, 0); PG8_LDB(B1, 1, 1); PG8_SCHED; PG8_LDA(At, 1, 0); PG8_STAGE(PG8_SA(0, 1), a2 + hstepA, voffA);
            PG8_WAIT_V(8); PG8_WAIT_L(0); PG8_BAR; PG8_MMA(0, 0, At, B0); PG8_MMA(0, 1, At, B1); PG8_BAR; PG8_SCHED;
            PG8_LDA(At, 1, 1); PG8_STAGE(PG8_SB(1, 0), b3, voffB); PG8_STAGE(PG8_SB(1, 1), b3 + hstepB, voffB); PG8_STAGE(PG8_SA(1, 0), a3, voffA);
            PG8_WAIT_V(8); PG8_WAIT_L(0); PG8_BAR; PG8_MMA(1, 0, At, B0); PG8_MMA(1, 1, At, B1); PG8_BAR; PG8_SCHED;
            } else {
            PG8_LDB(B0, 0, 0); PG8_SCHED; PG8_LDA(At, 0, 0); PG8_STAGE(PG8_SA(1, 1), a1 + hstepA, voffA);
            PG8_WAIT_L(8); PG8_BAR; PG8_WAIT_L(0); PG8_MMA(0, 0, At, B0); PG8_BAR; PG8_SCHED;
            PG8_LDB(B1, 0, 1); PG8_STAGE(PG8_SB(0, 0), b2, voffB);
            PG8_BAR; PG8_WAIT_L(0); PG8_MMA(0, 1, At, B1); PG8_BAR;
            PG8_LDA(At, 0, 1); PG8_STAGE(PG8_SA(0, 0), a2, voffA);
            PG8_BAR; PG8_WAIT_L(0); PG8_MMA(1, 0, At, B0); PG8_BAR; PG8_SCHED;
            PG8_STAGE(PG8_SB(0, 1), b2 + hstepB, voffB);
            PG8_WAIT_V(6); PG8_BAR; PG8_MMA(1, 1, At, B1); PG8_BAR;
            PG8_LDB(B0, 1, 0); PG8_SCHED; PG8_LDA(At, 1, 0); PG8_STAGE(PG8_SA(0, 1), a2 + hstepA, voffA);
            PG8_WAIT_L(8); PG8_BAR; PG8_WAIT_L(0); PG8_MMA(0, 0, At, B0); PG8_BAR; PG8_SCHED;
            PG8_LDB(B1, 1, 1); PG8_STAGE(PG8_SB(1, 0), b3, voffB);
            PG8_BAR; PG8_WAIT_L(0); PG8_MMA(0, 1, At, B1); PG8_BAR;
            PG8_LDA(At, 1, 1); PG8_STAGE(PG8_SA(1, 0), a3, voffA);
            PG8_BAR; PG8_WAIT_L(0); PG8_MMA(1, 0, At, B0); PG8_BAR; PG8_SCHED;
            PG8_STAGE(PG8_SB(1, 1), b3 + hstepB, voffB);
            PG8_WAIT_V(6); PG8_BAR; PG8_MMA(1, 1, At, B1); PG8_BAR;
            }
        }
        if constexpr (ALIGN_EPI) { if (wr == 0) PG8_BAR; }
        if constexpr (!Epi::AFTER_DRAIN) { E(acc, cur, wr, wc, fr, fq); S.done(cur); }
        if (!has_next) break;
#pragma unroll
        for (int a = 0; a < 2; ++a)
#pragma unroll
            for (int b = 0; b < 2; ++b)
#pragma unroll
                for (int m = 0; m < 4; ++m)
#pragma unroll
                    for (int n = 0; n < 2; ++n) acc[a][b][m][n] = (f32x4){0.f, 0.f, 0.f, 0.f};
        cur = nxt; cA = nA; cB = nB; ++ui;
        if constexpr (ALIGN_EPI) { if (wr == 1) PG8_BAR; }
    }
    PG8_WAIT_V(0);
    if constexpr (!ALIGN_EPI) { if (wr == 0) PG8_BAR; }
    PG8_BAR;
    if constexpr (Epi::AFTER_DRAIN) { E.fused(acc, cur, wr, wc, fr, fq, lds, wid, lane); S.done(cur); }
#undef PG8_SA
#undef PG8_SB
#undef PG8_STAGE
#undef PG8_LDA
#undef PG8_LDB
#undef PG8_MMA
#undef PG8_WAIT_V
#undef PG8_WAIT_L
#undef PG8_BAR
#undef PG8_SCHED
}
}
using pg8::bf16_t; using pg8::bf16x8; using pg8::f32x4; using pg8::u32x4; using pg8::cvt_pk_bf16;
#define LAS __attribute__((address_space(3)))
#define GAS __attribute__((address_space(1)))
typedef unsigned u32x2 __attribute__((ext_vector_type(2)));
#define DI __device__ __forceinline__

constexpr int D = 1024, BATCH = 16, SEQ = 4096, CTXL = 256, NH = 32;
constexpr int INP = 9472;
constexpr int NB = 8, T = NB * SEQ, NGRP = BATCH / NB, CT = BATCH * CTXL;
constexpr float EPS = 1e-6f;
constexpr int NTHR = 512;
constexpr int LDS_BYTES = 147456;

constexpr size_t MiB = 1u << 20;
constexpr size_t al256(size_t x) { return (x + 255) & ~(size_t)255; }
constexpr size_t WS_WIN = 0;
constexpr size_t WS_WPP = WS_WIN + al256((size_t)INP * 1024 * 2);
constexpr size_t WS_WPS = WS_WPP + 2 * MiB;
constexpr size_t WS_WO = WS_WPS + 4 * MiB;
constexpr size_t WS_PW = WS_WO + 2 * MiB;
constexpr size_t WS_MOD = WS_PW + MiB / 2;
constexpr size_t WS_HC = WS_MOD + al256(17 * 3072 * 4);
constexpr size_t WS_CXBC = WS_HC + (size_t)CT * 1024 * 2;
constexpr size_t WS_CDT = WS_CXBC + (size_t)CT * 3072 * 2;
constexpr size_t WS_CXT = WS_CDT + (size_t)CT * 64 * 4;
constexpr size_t WS_CBT = WS_CXT + (size_t)CT * 2048 * 2;
constexpr size_t WS_CDTV = WS_CBT + (size_t)CT * 512 * 2;
constexpr size_t WS_CACS = WS_CDTV + (size_t)2 * CT * 32 * 4;
constexpr size_t WS_HX = WS_CACS + (size_t)2 * CT * 32 * 4;
constexpr size_t WS_V = WS_HX + (size_t)T * 1024 * 2;
constexpr size_t WS_SZS = WS_V + (size_t)T * 1024 * 2;
constexpr size_t WS_GATES = WS_SZS + (size_t)T * 2048 * 2;
constexpr size_t WS_XBC = WS_GATES + (size_t)T * 2048 * 2;
constexpr size_t WS_DTR = WS_XBC + (size_t)T * 3072 * 2;
constexpr size_t WS_XT = WS_DTR + (size_t)T * 64 * 4;
constexpr size_t WS_CG = WS_XT + (size_t)T * 2048 * 2;
constexpr size_t WS_BT = WS_CG + (size_t)T * 512 * 2;
constexpr size_t WS_GT = WS_BT + (size_t)T * 512 * 2;
constexpr size_t WS_DTV = WS_GT + (size_t)T * 512 * 2;
constexpr size_t WS_ACS = WS_DTV + (size_t)2 * T * 32 * 4;
constexpr size_t WS_END = WS_ACS + (size_t)2 * T * 32 * 4;
constexpr size_t WS_BAR = al256(WS_END);
constexpr size_t WS_YF = WS_XBC, WS_YP = WS_XBC + (size_t)T * 2048 * 2, WS_YB = WS_HX, WS_MRG = WS_HX;
static_assert(WS_BAR + 16384 <= 1024 * MiB, "workspace map");

DI float bflo(unsigned w) { return __uint_as_float(w << 16); }
DI float bfhi(unsigned w) { return __uint_as_float(w & 0xffff0000u); }
DI float silu_f(float x) { return x * __builtin_amdgcn_rcpf(1.f + __expf(-x)); }
DI float sigm_f(float x) { return __builtin_amdgcn_rcpf(1.f + __expf(-x)); }
DI float wave_sum(float v, int lane) {
#pragma unroll
    for (int o = 1; o < 64; o <<= 1) v += __int_as_float(__builtin_amdgcn_ds_bpermute((lane ^ o) << 2, __float_as_int(v)));
    return v;
}
DI u32x4 pack8(const float* o) { u32x4 w; w.x = cvt_pk_bf16(o[0], o[1]); w.y = cvt_pk_bf16(o[2], o[3]); w.z = cvt_pk_bf16(o[4], o[5]); w.w = cvt_pk_bf16(o[6], o[7]); return w; }
DI void unpack8(u32x4 w, float* o) { o[0] = bflo(w.x); o[1] = bfhi(w.x); o[2] = bflo(w.y); o[3] = bfhi(w.y); o[4] = bflo(w.z); o[5] = bfhi(w.z); o[6] = bflo(w.w); o[7] = bfhi(w.w); }
#define MFMA16(a, b, c) __builtin_amdgcn_mfma_f32_16x16x32_bf16((a), (b), (c), 0, 0, 0)

DI int fresh_lane() { unsigned m = ~0u; asm volatile("" : "+s"(m)); int l = (int)__builtin_amdgcn_mbcnt_hi(m, __builtin_amdgcn_mbcnt_lo(m, 0u)); asm volatile("" : "+v"(l)); return l; }
struct EpiInProj {
    static constexpr bool PERM = true, AFTER_DRAIN = false;
    bf16_t *V, *SZP, *SZS, *GATES, *XBC; float* DT; const float* b_merge; int pn_base;
    __device__ __forceinline__ void operator()(const f32x4 (&acc)[2][2][4][2], const pg8::Unit& u, int wr, int wc, int, int) const { const int ln_ = fresh_lane(), fr = ln_ & 15, fq = ln_ >> 4;
        const int pn = u.pn + pn_base; int mode, ldc, colt; bf16_t* O;
        if (pn < 4) { mode = 0; O = V; ldc = 1024; colt = pn * 256; }
        else if (pn < 8) { mode = 1; O = SZP; ldc = 1024; colt = (pn - 4) * 256; }
        else if (pn < 16) { mode = 1; O = SZS; ldc = 2048; colt = (pn - 8) * 256; }
        else if (pn < 24) { mode = 2; O = GATES; ldc = 2048; colt = (pn - 16) * 256; }
        else if (pn < 36) { mode = 0; O = XBC; ldc = 3072; colt = (pn - 24) * 256; }
        else { mode = 3; O = nullptr; ldc = 64; colt = 0; }
        const int row0 = u.pm * 256 + wr * 64 + fr;
        if (mode == 3) {
            if (wc < 2) {
#pragma unroll
                for (int ai = 0; ai < 2; ++ai)
#pragma unroll
                    for (int m = 0; m < 4; ++m) { float* rp = DT + (size_t)(row0 + ai * 128 + m * 16) * 64 + wc * 32 + 8 * fq;
                        *(GAS f32x4*)rp = acc[ai][0][m][0]; *(GAS f32x4*)(rp + 4) = acc[ai][0][m][1]; }
            }
            return;
        }
        const int col0 = colt + wc * 32 + 8 * fq;
#define INPROJ_WALK(...) \
        _Pragma("unroll") for (int ai = 0; ai < 2; ++ai) _Pragma("unroll") for (int m = 0; m < 4; ++m) { bf16_t* rowp = O + (size_t)(row0 + ai * 128 + m * 16) * ldc + col0; \
            _Pragma("unroll") for (int bj = 0; bj < 2; ++bj) { f32x4 v0 = acc[ai][bj][m][0], v1 = acc[ai][bj][m][1]; __VA_ARGS__ \
                u32x4 w; w.x = cvt_pk_bf16(v0[0], v0[1]); w.y = cvt_pk_bf16(v0[2], v0[3]); w.z = cvt_pk_bf16(v1[0], v1[1]); w.w = cvt_pk_bf16(v1[2], v1[3]); \
                *(GAS u32x4*)(rowp + bj * 128) = w; } asm volatile("" ::: "memory"); }
        if (mode == 0) { INPROJ_WALK() }
        else if (mode == 1) { INPROJ_WALK(_Pragma("unroll") for (int e = 0; e < 4; ++e) { v0[e] = silu_f(v0[e]); v1[e] = silu_f(v1[e]); }) }
        else { f32x4 bm[2][2];
            _Pragma("unroll") for (int bj = 0; bj < 2; ++bj) { bm[bj][0] = *(const GAS f32x4*)(b_merge + col0 + bj * 128); bm[bj][1] = *(const GAS f32x4*)(b_merge + col0 + bj * 128 + 4); }
            INPROJ_WALK({ _Pragma("unroll") for (int e = 0; e < 4; ++e) { v0[e] = sigm_f(v0[e] + bm[bj][0][e]); v1[e] = sigm_f(v1[e] + bm[bj][1][e]); } }) }
#undef INPROJ_WALK
    }
};
#define EPI_WALK(...) \
    const int row0_ = u.pm * 256 + wr * 64 + fr, col0_ = u.pn * 256 + wc * 32 + 8 * fq; \
    _Pragma("unroll") for (int ai = 0; ai < 2; ++ai) _Pragma("unroll") for (int m = 0; m < 4; ++m) { const size_t row = (size_t)(row0_ + ai * 128 + m * 16); \
    _Pragma("unroll") for (int bj = 0; bj < 2; ++bj) { const int col = col0_ + bj * 128; const f32x4 v0 = acc[ai][bj][m][0], v1 = acc[ai][bj][m][1]; __VA_ARGS__ } asm volatile("" ::: "memory"); }

#define EPI_ROW(g_) ((size_t)(row0_ + ((g_) >> 2) * 128 + ((g_) & 3) * 16))
struct EpiPool {
    static constexpr bool PERM = true, AFTER_DRAIN = false;
    bf16_t* YP; const bf16_t* SZP; const float* pscale;
    __device__ __forceinline__ void operator()(const f32x4 (&acc)[2][2][4][2], const pg8::Unit& u, int wr, int wc, int, int) const { const int ln_ = fresh_lane(), fr = ln_ & 15, fq = ln_ >> 4;
        const int row0_ = u.pm * 256 + wr * 64 + fr, col0_ = u.pn * 256 + wc * 32 + 8 * fq;
        f32x4 ps[2][2];
#pragma unroll
        for (int bj = 0; bj < 2; ++bj) { ps[bj][0] = *(const GAS f32x4*)(pscale + col0_ + bj * 128); ps[bj][1] = *(const GAS f32x4*)(pscale + col0_ + bj * 128 + 4); }
        u32x4 cur[2], nxt[2];
#pragma unroll
        for (int bj = 0; bj < 2; ++bj) { cur[bj] = *(const GAS u32x4*)(SZP + EPI_ROW(0) * 1024 + col0_ + bj * 128); nxt[bj] = cur[bj]; }
#pragma unroll
        for (int g = 0; g < 8; ++g) { const int ai = g >> 2, m = g & 3;
            if (g < 7) {
#pragma unroll
                for (int bj = 0; bj < 2; ++bj) nxt[bj] = *(const GAS u32x4*)(SZP + EPI_ROW(g + 1) * 1024 + col0_ + bj * 128); }
            asm volatile("" ::: "memory");
#pragma unroll
            for (int bj = 0; bj < 2; ++bj) { const f32x4 v0 = acc[ai][bj][m][0], v1 = acc[ai][bj][m][1]; float z[8]; unpack8(cur[bj], z); float o[8];
#pragma unroll
                for (int e = 0; e < 4; ++e) { o[e] = v0[e] * ps[bj][0][e] * z[e]; o[4 + e] = v1[e] * ps[bj][1][e] * z[4 + e]; }
                *(GAS u32x4*)(YP + EPI_ROW(g) * 1024 + col0_ + bj * 128) = pack8(o); }
#pragma unroll
            for (int bj = 0; bj < 2; ++bj) cur[bj] = nxt[bj]; }
    }
};
struct EpiM1 {
    static constexpr bool PERM = true, AFTER_DRAIN = false;
    float* TMP; const bf16_t* GATES;
    __device__ __forceinline__ void operator()(const f32x4 (&acc)[2][2][4][2], const pg8::Unit& u, int wr, int wc, int, int) const { const int ln_ = fresh_lane(), fr = ln_ & 15, fq = ln_ >> 4;
        const int row0_ = u.pm * 256 + wr * 64 + fr, col0_ = u.pn * 256 + wc * 32 + 8 * fq;
        u32x4 cur[2], nxt[2];
#pragma unroll
        for (int bj = 0; bj < 2; ++bj) { cur[bj] = *(const GAS u32x4*)(GATES + EPI_ROW(0) * 2048 + col0_ + bj * 128); nxt[bj] = cur[bj]; }
#pragma unroll
        for (int g = 0; g < 8; ++g) { const int ai = g >> 2, m = g & 3;
            if (g < 7) {
#pragma unroll
                for (int bj = 0; bj < 2; ++bj) nxt[bj] = *(const GAS u32x4*)(GATES + EPI_ROW(g + 1) * 2048 + col0_ + bj * 128); }
            asm volatile("" ::: "memory");
#pragma unroll
            for (int bj = 0; bj < 2; ++bj) { const f32x4 v0 = acc[ai][bj][m][0], v1 = acc[ai][bj][m][1]; float gt[8]; unpack8(cur[bj], gt); f32x4 o0, o1;
#pragma unroll
                for (int e = 0; e < 4; ++e) { o0[e] = v0[e] * gt[e]; o1[e] = v1[e] * gt[4 + e]; }
                float* tp = TMP + EPI_ROW(g) * 1024 + col0_ + bj * 128; *(GAS f32x4*)tp = o0; *(GAS f32x4*)(tp + 4) = o1; }
#pragma unroll
            for (int bj = 0; bj < 2; ++bj) cur[bj] = nxt[bj]; }
    }
};
struct EpiM2 {
    static constexpr bool PERM = true, AFTER_DRAIN = false;
    const float* TMP; const bf16_t* GATES; bf16_t* MRG;
    __device__ __forceinline__ void operator()(const f32x4 (&acc)[2][2][4][2], const pg8::Unit& u, int wr, int wc, int, int) const { const int ln_ = fresh_lane(), fr = ln_ & 15, fq = ln_ >> 4;
        const int row0_ = u.pm * 256 + wr * 64 + fr, col0_ = u.pn * 256 + wc * 32 + 8 * fq;
        u32x4 cg_[2], ng_[2]; f32x4 ct_[2][2], nt_[2][2];
#pragma unroll
        for (int bj = 0; bj < 2; ++bj) { cg_[bj] = *(const GAS u32x4*)(GATES + EPI_ROW(0) * 2048 + 1024 + col0_ + bj * 128); const float* tp = TMP + EPI_ROW(0) * 1024 + col0_ + bj * 128; ct_[bj][0] = *(const GAS f32x4*)tp; ct_[bj][1] = *(const GAS f32x4*)(tp + 4);
            ng_[bj] = cg_[bj]; nt_[bj][0] = ct_[bj][0]; nt_[bj][1] = ct_[bj][1]; }
#pragma unroll
        for (int g = 0; g < 8; ++g) { const int ai = g >> 2, m = g & 3;
            if (g < 7) {
#pragma unroll
                for (int bj = 0; bj < 2; ++bj) { ng_[bj] = *(const GAS u32x4*)(GATES + EPI_ROW(g + 1) * 2048 + 1024 + col0_ + bj * 128); const float* tp = TMP + EPI_ROW(g + 1) * 1024 + col0_ + bj * 128; nt_[bj][0] = *(const GAS f32x4*)tp; nt_[bj][1] = *(const GAS f32x4*)(tp + 4); } }
            asm volatile("" ::: "memory");
#pragma unroll
            for (int bj = 0; bj < 2; ++bj) { const f32x4 v0 = acc[ai][bj][m][0], v1 = acc[ai][bj][m][1]; float gt[8]; unpack8(cg_[bj], gt); float o[8];
#pragma unroll
                for (int e = 0; e < 4; ++e) { o[e] = ct_[bj][0][e] + v0[e] * gt[e]; o[4 + e] = ct_[bj][1][e] + v1[e] * gt[4 + e]; }
                *(GAS u32x4*)(MRG + EPI_ROW(g) * 1024 + col0_ + bj * 128) = pack8(o); }
#pragma unroll
            for (int bj = 0; bj < 2; ++bj) { cg_[bj] = ng_[bj]; ct_[bj][0] = nt_[bj][0]; ct_[bj][1] = nt_[bj][1]; } }
    }
};
struct EpiF32 {
    static constexpr bool PERM = true, AFTER_DRAIN = false;
    float* O;
    __device__ __forceinline__ void operator()(const f32x4 (&acc)[2][2][4][2], const pg8::Unit& u, int wr, int wc, int, int) const { const int ln_ = fresh_lane(), fr = ln_ & 15, fq = ln_ >> 4;
        EPI_WALK({ *(GAS f32x4*)(O + row * 1024 + col) = v0; *(GAS f32x4*)(O + row * 1024 + col + 4) = v1; })
    }
};
DI void transpose_item(const float* W, int K, int N, bf16_t* WT, int ldo, int row_off, LAS float* scr, int item, int lane) {
    const int nblk = N / 32, kb = item / nblk, nb = item % nblk, k0 = 64 * kb, n0 = 32 * nb;
#pragma unroll 8
    for (int i = 0; i < 32; ++i) { const int kk = 2 * i + (lane >> 5); scr[kk * 33 + (lane & 31)] = ((const GAS float*)W)[(size_t)(k0 + kk) * N + n0 + (lane & 31)]; }
    asm volatile("s_waitcnt lgkmcnt(0)" ::: "memory");
    const int c = lane & 7;
#pragma unroll
    for (int j = 0; j < 4; ++j) { const int n = (lane >> 3) + 8 * j; const LAS float* s = scr + (8 * c) * 33 + n;
        u32x4 o; o.x = cvt_pk_bf16(s[0 * 33], s[1 * 33]); o.y = cvt_pk_bf16(s[2 * 33], s[3 * 33]); o.z = cvt_pk_bf16(s[4 * 33], s[5 * 33]); o.w = cvt_pk_bf16(s[6 * 33], s[7 * 33]);
        *(GAS u32x4*)(WT + (size_t)(row_off + n0 + n) * ldo + k0 + 8 * c) = o; }
    asm volatile("s_waitcnt lgkmcnt(0)" ::: "memory");
}
DI void mod_item(LAS unsigned char* lds, const float* c, const float* c_ctx, const float* w_ada, const float* b_ada, float* MOD, int item, int tid) {
    LAS float* sS = (LAS float*)lds;
    LAS float* sP = (LAS float*)(lds + 17 * 1024 * 4);
    for (int i = tid; i < 17 * 1024; i += NTHR) { const float v = i < 16 * 1024 ? ((const GAS float*)c)[i] : ((const GAS float*)c_ctx)[i - 16 * 1024]; sS[i] = silu_f(v); }
    __syncthreads();
    const int col = tid & 63, kseg = tid >> 6, n = item * 64 + col;
    float acc[17];
#pragma unroll
    for (int r = 0; r < 17; ++r) acc[r] = 0.f;
    for (int k = kseg * 128; k < kseg * 128 + 128; ++k) { const float w = ((const GAS float*)w_ada)[(size_t)k * 3072 + n];
#pragma unroll
        for (int r = 0; r < 17; ++r) acc[r] += sS[r * 1024 + k] * w; }
#pragma unroll
    for (int r = 0; r < 17; ++r) sP[(kseg * 17 + r) * 64 + col] = acc[r];
    __syncthreads();
    for (int i = tid; i < 17 * 64; i += NTHR) { const int r = i >> 6, cc = i & 63; float s = ((const GAS float*)b_ada)[item * 64 + cc];
#pragma unroll
        for (int q = 0; q < 8; ++q) s += sP[(q * 17 + r) * 64 + cc];
        ((GAS float*)MOD)[r * 3072 + item * 64 + cc] = s; }
    __syncthreads();
}
DI void modnorm_row(const float* xrow, const float* npre, const float* mod, bf16_t* orow, int lane) {
    f32x4 v[4]; float ss = 0.f;
#pragma unroll
    for (int j = 0; j < 4; ++j) { v[j] = *(const GAS f32x4*)(xrow + 4 * lane + 256 * j); ss += (v[j].x * v[j].x + v[j].y * v[j].y) + (v[j].z * v[j].z + v[j].w * v[j].w); }
    const float rstd = rsqrtf(wave_sum(ss, lane) * (1.f / 1024.f) + EPS);
#pragma unroll
    for (int j = 0; j < 4; ++j) { const int c0 = 4 * lane + 256 * j; const f32x4 w = *(const GAS f32x4*)(npre + c0), sh = *(const GAS f32x4*)(mod + c0), sc = *(const GAS f32x4*)(mod + 1024 + c0);
        f32x4 o;
#pragma unroll
        for (int e = 0; e < 4; ++e) o[e] = v[j][e] * rstd * w[e] * (1.f + sc[e]) + sh[e];
        u32x2 p; p.x = cvt_pk_bf16(o[0], o[1]); p.y = cvt_pk_bf16(o[2], o[3]); *(GAS u32x2*)(orow + c0) = p; }
}
DI void final_row(float* yrow, const float* xrow, const float* npost, const float* gate, int lane) {
    f32x4 v[4]; float ss = 0.f;
#pragma unroll
    for (int j = 0; j < 4; ++j) { v[j] = *(const GAS f32x4*)(yrow + 4 * lane + 256 * j); ss += (v[j].x * v[j].x + v[j].y * v[j].y) + (v[j].z * v[j].z + v[j].w * v[j].w); }
    const float rstd = rsqrtf(wave_sum(ss, lane) * (1.f / 1024.f) + EPS);
#pragma unroll
    for (int j = 0; j < 4; ++j) { const int c0 = 4 * lane + 256 * j; const f32x4 w = *(const GAS f32x4*)(npost + c0), g = *(const GAS f32x4*)(gate + c0), x = *(const GAS f32x4*)(xrow + c0);
        f32x4 o;
#pragma unroll
        for (int e = 0; e < 4; ++e) o[e] = x[e] + g[e] * (v[j][e] * rstd * w[e]);
        *(GAS f32x4*)(yrow + c0) = o; }
}
DI void gnorm_item(bf16_t* yf, const bf16_t* yb, const bf16_t* szs, const float* w, int lane) {
    float a[8], b[8], z[8], u[8]; unpack8(*(const GAS u32x4*)(yf + lane * 8), a); unpack8(*(const GAS u32x4*)(yb + lane * 8), b); unpack8(*(const GAS u32x4*)(szs + lane * 8), z);
    float ss = 0.f;
#pragma unroll
    for (int e = 0; e < 8; ++e) { u[e] = (a[e] + b[e]) * z[e]; ss += u[e] * u[e]; }
    const float r = rsqrtf(wave_sum(ss, lane) * (1.f / 512.f) + EPS);
    const f32x4 w0 = *(const GAS f32x4*)(w + lane * 8), w1 = *(const GAS f32x4*)(w + lane * 8 + 4);
    float o[8];
#pragma unroll
    for (int e = 0; e < 4; ++e) { o[e] = u[e] * r * w0[e]; o[4 + e] = u[4 + e] * r * w1[e]; }
    *(GAS u32x4*)(yf + lane * 8) = pack8(o);
}

constexpr int RS = 272;
DI void conv_xs_wave(LAS unsigned char* wl, const bf16_t* src, int L, int c, int hb, bf16_t* dst_tile, const float* conv_w, const float* conv_b, int lane) {
    const int cp = lane & 31, th = lane >> 5, ch = hb * 64 + 2 * cp;
    float w0[4], w1[4];
#pragma unroll
    for (int k = 0; k < 4; ++k) { w0[k] = ((const GAS float*)conv_w)[k * 3072 + ch]; w1[k] = ((const GAS float*)conv_w)[k * 3072 + ch + 1]; }
    const float b0 = ((const GAS float*)conv_b)[ch], b1 = ((const GAS float*)conv_b)[ch + 1];
    const int t0 = c * 128 + th * 64 - 2;
    unsigned raw[67];
#pragma unroll
    for (int r = 0; r < 67; ++r) { const int t = t0 + r; raw[r] = 0u; if (t >= 0 && t < L) raw[r] = *(const GAS unsigned*)(src + (size_t)t * 3072 + ch); }
#pragma unroll
    for (int blk = 0; blk < 8; ++blk) { float o0[8], o1[8];
#pragma unroll
        for (int u = 0; u < 8; ++u) { float s0 = b0, s1 = b1;
#pragma unroll
            for (int k = 0; k < 4; ++k) { s0 += w0[k] * bflo(raw[blk * 8 + u + k]); s1 += w1[k] * bfhi(raw[blk * 8 + u + k]); }
            o0[u] = silu_f(s0); o1[u] = silu_f(s1); }
        *(LAS u32x4*)(wl + (2 * cp) * RS + (th * 64 + blk * 8) * 2) = pack8(o0);
        *(LAS u32x4*)(wl + (2 * cp + 1) * RS + (th * 64 + blk * 8) * 2) = pack8(o1); }
    asm volatile("s_waitcnt lgkmcnt(0)" ::: "memory");
#pragma unroll
    for (int q = 0; q < 16; ++q) { const int row = q * 4 + (lane >> 4), cb = (lane & 15) * 16;
        *(GAS u32x4*)((char*)dst_tile + row * 256 + cb) = *(const LAS u32x4*)(wl + row * RS + cb); }
    asm volatile("s_waitcnt lgkmcnt(0)" ::: "memory");
}
DI void conv_bc_item(LAS unsigned char* lds, const bf16_t* src, int L, int c, int g, bf16_t* bt_tile, bf16_t* cg_rows, bf16_t* gt_tile, const float* conv_w, const float* conv_b, int tid) {
    LAS unsigned char* sB = lds; LAS unsigned char* sC = lds + 128 * RS;
    {
        const int p_ = tid & 127, tq = tid >> 7, mat = p_ >> 6, n2 = 2 * (p_ & 63), ch = 2048 + mat * 512 + g * 128 + n2;
        LAS unsigned char* sM = mat ? sC : sB;
        float w0[4], w1[4];
#pragma unroll
        for (int k = 0; k < 4; ++k) { w0[k] = ((const GAS float*)conv_w)[k * 3072 + ch]; w1[k] = ((const GAS float*)conv_w)[k * 3072 + ch + 1]; }
        const float b0 = ((const GAS float*)conv_b)[ch], b1 = ((const GAS float*)conv_b)[ch + 1];
        unsigned raw[4][11];
#pragma unroll
        for (int ps = 0; ps < 4; ++ps)
#pragma unroll
            for (int r = 0; r < 11; ++r) { const int t = c * 128 + (ps * 4 + tq) * 8 - 2 + r; raw[ps][r] = 0u; if (t >= 0 && t < L) raw[ps][r] = *(const GAS unsigned*)(src + (size_t)t * 3072 + ch); }
#pragma unroll
        for (int ps = 0; ps < 4; ++ps) { const int tk0 = (ps * 4 + tq) * 8; float o0[8], o1[8];
#pragma unroll
            for (int u = 0; u < 8; ++u) { float s0 = b0, s1 = b1;
#pragma unroll
                for (int k = 0; k < 4; ++k) { s0 += w0[k] * bflo(raw[ps][u + k]); s1 += w1[k] * bfhi(raw[ps][u + k]); }
                o0[u] = silu_f(s0); o1[u] = silu_f(s1);
                *(LAS unsigned*)(sM + (tk0 + u) * RS + n2 * 2) = cvt_pk_bf16(o0[u], o1[u]); }
            if (mat == 0) { const int cb_ = ((tk0 >> 5) * 64 + ((tk0 >> 3) & 3) * 16) * 16;
                *(GAS u32x4*)((char*)bt_tile + ((n2 >> 4) * 4096 + cb_ + (n2 & 15) * 16)) = pack8(o0); *(GAS u32x4*)((char*)bt_tile + (((n2 + 1) >> 4) * 4096 + cb_ + ((n2 + 1) & 15) * 16)) = pack8(o1); } }
    }
    __syncthreads();
    if (cg_rows) {
#pragma unroll
        for (int q = 0; q < 4; ++q) { const int f = tid + 512 * q, rb = f >> 8, ks = (f >> 6) & 3, ln = f & 63;
            *(GAS u32x4*)((char*)cg_rows + f * 16) = *(const LAS u32x4*)(sC + (rb * 16 + (ln & 15)) * RS + (ks * 32 + (ln >> 4) * 8) * 2); } }
    if (gt_tile) { const int wid = tid >> 6, lane = tid & 63, fr = lane & 15, fq = lane >> 4;
        f32x4 acc[8];
#pragma unroll
        for (int jb = 0; jb < 8; ++jb) acc[jb] = (f32x4){0.f, 0.f, 0.f, 0.f};
#pragma unroll
        for (int ks = 0; ks < 4; ++ks) { const bf16x8 cf = *(const LAS bf16x8*)(sC + (16 * wid + fr) * RS + (ks * 32 + fq * 8) * 2);
#pragma unroll
            for (int jb = 0; jb < 8; ++jb) { const bf16x8 bfr = *(const LAS bf16x8*)(sB + (jb * 16 + fr) * RS + (ks * 32 + fq * 8) * 2); acc[jb] = MFMA16(bfr, cf, acc[jb]); } }
#pragma unroll
        for (int jb = 0; jb < 8; ++jb) { u32x2 p; p.x = cvt_pk_bf16(acc[jb][0], acc[jb][1]); p.y = cvt_pk_bf16(acc[jb][2], acc[jb][3]);
            *(GAS u32x2*)((char*)gt_tile + ((wid * 4 + (jb >> 1)) * 1024 + (((jb & 1) * 2 + (fq >> 1)) * 16 + fr) * 16 + (fq & 1) * 8)) = p; } }
    __syncthreads();
}
constexpr float LOG2E = 1.4426950408889634f;
DI void dt_item(LAS unsigned char* lds, const float* dtr, int L, int c, float* dtv, float* acs, size_t dir_stride, const float* dt_bias, const float* a_log, int tid) {
    LAS float* sTot = (LAS float*)lds;
    const int col = tid & 63, seg = tid >> 6, dir = col >> 5, h = col & 31;
    const float bias = ((const GAS float*)dt_bias)[col], A = -__expf(((const GAS float*)a_log)[col]);
    float dtl[16], cs[16];
#pragma unroll
    for (int u = 0; u < 16; ++u) { const float x = ((const GAS float*)dtr)[(size_t)(c * 128 + seg * 16 + u) * 64 + col] + bias; dtl[u] = x > 20.f ? x : log1pf(expf(x)); }
    float run = 0.f;
    if (dir == 0) {
#pragma unroll
        for (int u = 0; u < 16; ++u) { run += dtl[u] * A; cs[u] = run; }
    } else {
#pragma unroll
        for (int u = 15; u >= 0; --u) { run += dtl[u] * A; cs[u] = run; }
    }
    sTot[seg * 64 + col] = run;
    __syncthreads();
    float off = 0.f;
#pragma unroll
    for (int s = 0; s < 8; ++s) { const float v = sTot[s * 64 + col]; if (dir == 0 ? (s < seg) : (s > seg)) off += v; }
    const size_t o = (size_t)dir * dir_stride + (size_t)h * L + c * 128 + seg * 16;
#pragma unroll
    for (int q = 0; q < 4; ++q) { *(GAS f32x4*)(dtv + o + 4 * q) = (f32x4){dtl[4 * q], dtl[4 * q + 1], dtl[4 * q + 2], dtl[4 * q + 3]};
        *(GAS f32x4*)(acs + o + 4 * q) = (f32x4){(cs[4 * q] + off) * LOG2E, (cs[4 * q + 1] + off) * LOG2E, (cs[4 * q + 2] + off) * LOG2E, (cs[4 * q + 3] + off) * LOG2E}; }
    __syncthreads();
}
DI void pool_wave(LAS unsigned char* wl, const bf16_t* v, bf16_t* dd, int r, int gi, int cq, int lane) {
    LAS float* sV = (LAS float*)wl;
    const int k = 2 << gi, lo = k >> 1, hi = k - 1 - lo;
    const int c8 = lane & 7, wq = lane >> 3, ch = gi * 256 + cq * 64 + c8 * 8;
    const int r_lo = max(r - lo, 0), r_hi = min(r + hi + 1, 64);
    const float inv_r = 1.f / (float)(r_hi - r_lo);
    float acc[8][8]; u32x4 ctr[8];
#pragma unroll
    for (int q = 0; q < 8; ++q) { ctr[q] = (u32x4){0u, 0u, 0u, 0u};
#pragma unroll
        for (int e = 0; e < 8; ++e) acc[q][e] = 0.f; }
    for (int rr = r_lo; rr < r_hi; ++rr) { u32x4 x[8];
#pragma unroll
        for (int q = 0; q < 8; ++q) x[q] = *(const GAS u32x4*)(v + ((size_t)(rr * 64 + wq * 8 + q) * 1024 + ch));
#pragma unroll
        for (int q = 0; q < 8; ++q) { float f[8]; unpack8(x[q], f);
#pragma unroll
            for (int e = 0; e < 8; ++e) acc[q][e] += f[e];
            if (rr == r) ctr[q] = x[q]; } }
#pragma unroll
    for (int q = 0; q < 8; ++q) { LAS float* p = sV + (wq * 8 + q) * 68 + c8 * 8;
        *(LAS f32x4*)p = (f32x4){acc[q][0] * inv_r, acc[q][1] * inv_r, acc[q][2] * inv_r, acc[q][3] * inv_r};
        *(LAS f32x4*)(p + 4) = (f32x4){acc[q][4] * inv_r, acc[q][5] * inv_r, acc[q][6] * inv_r, acc[q][7] * inv_r}; }
    asm volatile("s_waitcnt lgkmcnt(0)" ::: "memory");
    const int wb = wq * 8;
    f32x4 s0 = (f32x4){0.f, 0.f, 0.f, 0.f}, s1 = s0;
    for (int ww = max(wb - lo, 0); ww < min(wb + hi + 1, 64); ++ww) { const LAS float* p = sV + ww * 68 + c8 * 8; s0 += *(const LAS f32x4*)p; s1 += *(const LAS f32x4*)(p + 4); }
#pragma unroll
    for (int q = 0; q < 8; ++q) { const int w = wb + q, w_lo = max(w - lo, 0), w_hi = min(w + hi + 1, 64);
        const float inv_w = 1.f / (float)(w_hi - w_lo); float cv[8]; unpack8(ctr[q], cv); float o[8];
#pragma unroll
        for (int e = 0; e < 4; ++e) { o[e] = s0[e] * inv_w - cv[e]; o[4 + e] = s1[e] * inv_w - cv[4 + e]; }
        *(GAS u32x4*)(dd + ((size_t)(r * 64 + w) * 1024 + ch)) = pack8(o);
        if (q < 7) { const int wa = w + 1 + hi, ws_ = w - lo;
            if (wa < 64) { const LAS float* p = sV + wa * 68 + c8 * 8; s0 += *(const LAS f32x4*)p; s1 += *(const LAS f32x4*)(p + 4); }
            if (ws_ >= 0) { const LAS float* p = sV + ws_ * 68 + c8 * 8; s0 -= *(const LAS f32x4*)p; s1 -= *(const LAS f32x4*)(p + 4); } } }
    asm volatile("s_waitcnt lgkmcnt(0)" ::: "memory");
}
#define LDS_BARRIER() do { asm volatile("s_waitcnt lgkmcnt(0)" ::: "memory"); __builtin_amdgcn_s_barrier(); asm volatile("" ::: "memory"); } while (0)
DI void ssd_phase(LAS unsigned char* lds, const unsigned char* ws, const float* d_skip_p, int b0, int vcu, int G, int tid_in) {
    int tid_l = tid_in; asm volatile("" : "+v"(tid_l));
    const int tid = tid_l, wid = __builtin_amdgcn_readfirstlane(tid >> 6), lane = tid & 63, fr = lane & 15, fq = lane >> 4;
    constexpr int TILE = 64 * RS, OFF_HB = 2 * TILE, OFF_SC = 4 * TILE;
    const unsigned lb = (unsigned)(size_t)lds;
    unsigned a_frag = lb + fr * RS + fq * 16, a_f = lb + OFF_SC + fq * 32, a_xw = lb + (tid >> 3) * RS + (tid & 7) * 32, a_hw = lb + OFF_HB + fr * RS + wid * 32 + fq * 8,
             a_ai = lb + OFF_SC + 512 + (wid * 16 + fr) * 4, a_sc = lb + OFF_SC;
    asm volatile("" : "+v"(a_frag), "+v"(a_f), "+v"(a_xw), "+v"(a_hw), "+v"(a_ai), "+v"(a_sc));
    unsigned ln_bt = wid * 4096 + lane * 16, ln_xt = tid * 32;
    asm volatile("" : "+v"(ln_bt), "+v"(ln_xt));
#define LN_DA() ({ unsigned t_ = ln_xt; asm volatile("" : "+v"(t_)); t_ >> 3; })
#define LN_Y() ({ unsigned t_ = ln_bt; asm volatile("" : "+v"(t_)); ((t_ >> 12) << 16) | (((t_ >> 4) & 15u) << 12) | (((t_ >> 8) & 3u) << 3); })
#define XTF(q, pb, ks) (*(const LAS bf16x8*)(a_frag + ((q) * TILE + (pb) * 16 * RS + (ks) * 64)))
#define HBF(q, pb, ks) (*(const LAS bf16x8*)(a_frag + (OFF_HB + (q) * TILE + (pb) * 16 * RS + (ks) * 64)))
#define SCV(q, arr, ks, half) (*(const LAS f32x4*)(a_f + ((q) * 2048 + (arr) * 512 + (ks) * 128 + (half) * 16)))
    for (int pair = vcu; pair < NB * 32; pair += G) {
        const int hh = pair & 7, g = (pair >> 3) & 3, bl = pair >> 5, h = g * 8 + hh, bg = b0 + bl;
        const float dsk = ((const GAS float*)d_skip_p)[h];
        f32x4 accH[2][4];
        u32x4 xt0[2], xt1[2]; bf16x8 bt[2][4], gt[2][4], cgf[2][4]; float r_dt[2], r_acs[2], r_alast[2], r_ref[2];
#pragma unroll
        for (int q = 0; q < 2; ++q) { xt0[q] = (u32x4){0u, 0u, 0u, 0u}; xt1[q] = xt0[q]; r_dt[q] = 0.f; r_acs[q] = 0.f; r_alast[q] = 0.f; r_ref[q] = 0.f;
#pragma unroll
            for (int k = 0; k < 4; ++k) { accH[q][k] = (f32x4){0.f, 0.f, 0.f, 0.f}; bt[q][k] = (bf16x8){0, 0, 0, 0, 0, 0, 0, 0}; gt[q][k] = bt[q][k]; cgf[q][k] = bt[q][k]; } }
#define UNI(v_) asm volatile("" : "+s"(v_))
#define SSD_LOAD_XT_DA(q, s_) do { const int s__ = (s_); unsigned xo, dof, aof; \
        if (s__ < 2) { const int cc = q == 0 ? s__ : 1 - s__; xo = (unsigned)WS_CXT + (unsigned)((bg * 2 + cc) * 2048 + h * 64) * 256u; const unsigned o = ((unsigned)((q * 16 + bg) * 32 + h) * 256u + cc * 128) * 4u; dof = (unsigned)WS_CDTV + o; aof = (unsigned)WS_CACS + o; } \
        else { const int c_ = q == 0 ? s__ - 2 : 33 - s__; xo = (unsigned)WS_XT + (unsigned)((bl * 32 + c_) * 2048 + h * 64) * 256u; const unsigned o = ((unsigned)((q * NB + bl) * 32 + h) * 4096u + c_ * 128) * 4u; dof = (unsigned)WS_DTV + o; aof = (unsigned)WS_ACS + o; } \
        UNI(xo); UNI(dof); UNI(aof); const unsigned char* xp = ws + xo; const unsigned char* dp = ws + dof; const unsigned char* ap = ws + aof; \
        xt0[q] = *(const GAS u32x4*)(xp + ln_xt); xt1[q] = *(const GAS u32x4*)(xp + ln_xt + 16); \
        if (tid < 128) { const unsigned ln_da = LN_DA(); r_dt[q] = *(const GAS float*)(dp + ln_da); r_acs[q] = *(const GAS float*)(ap + ln_da); r_ref[q] = *(const GAS float*)(ap + (q == 0 ? (ln_da | 124u) : (ln_da & ~124u))); } r_alast[q] = *(const GAS float*)(ap + (q == 0 ? 127 * 4 : 0)); } while (0)
#define SSD_LOAD_BT(q, s_) do { const int s__ = (s_); unsigned bo; \
        if (s__ < 2) { const int cc = q == 0 ? s__ : 1 - s__; bo = (unsigned)WS_CBT + (unsigned)((bg * 2 + cc) * 512 + g * 128) * 256u; } \
        else { const int c_ = q == 0 ? s__ - 2 : 33 - s__; bo = (unsigned)WS_BT + (unsigned)((bl * 32 + c_) * 512 + g * 128) * 256u; } \
        UNI(bo); const unsigned char* bp = ws + bo; \
        _Pragma("unroll") for (int ks = 0; ks < 4; ++ks) bt[q][ks] = *(const GAS bf16x8*)(bp + ln_bt + ks * 1024); } while (0)
#define SSD_LOAD_GT_CG(q, s_) do { const int c_ = q == 0 ? (s_) - 2 : 33 - (s_); \
        unsigned go = (unsigned)WS_GT + (unsigned)(((bl * 32 + c_) * 4 + g) * 128) * 256u, co = (unsigned)WS_CG + (unsigned)(((bl * 32 + c_) * 4 + g) * 128) * 256u; \
        UNI(go); UNI(co); const unsigned char* gp = ws + go; const unsigned char* cp_ = ws + co; \
        _Pragma("unroll") for (int ks = 0; ks < 4; ++ks) { gt[q][ks] = *(const GAS bf16x8*)(gp + ln_bt + ks * 1024); cgf[q][ks] = *(const GAS bf16x8*)(cp_ + ln_bt + ks * 1024); } } while (0)
        SSD_LOAD_XT_DA(0, 0); SSD_LOAD_XT_DA(1, 0); SSD_LOAD_BT(0, 0); SSD_LOAD_BT(1, 0);
        for (int s = 0; s < 34; ++s) {
            float alast[2];
#pragma unroll
            for (int q = 0; q < 2; ++q) {
                *(LAS u32x4*)(a_xw + q * TILE) = xt0[q]; *(LAS u32x4*)(a_xw + (q * TILE + 16)) = xt1[q];
#pragma unroll
                for (int pb = 0; pb < 4; ++pb) { u32x2 pk; pk.x = cvt_pk_bf16(accH[q][pb][0], accH[q][pb][1]); pk.y = cvt_pk_bf16(accH[q][pb][2], accH[q][pb][3]);
                    *(LAS u32x2*)(a_hw + (q * TILE + pb * 16 * RS)) = pk; }
                alast[q] = r_alast[q];
                if (tid < 128) { const unsigned a_sw = a_sc + LN_DA(); *(LAS float*)(a_sw + q * 2048) = r_dt[q]; *(LAS float*)(a_sw + (q * 2048 + 512)) = r_acs[q]; *(LAS float*)(a_sw + (q * 2048 + 1024)) = r_dt[q] * __builtin_amdgcn_exp2f(alast[q] - r_acs[q]);
                    *(LAS float*)(a_sw + (q * 2048 + 1536)) = r_dt[q] * __builtin_amdgcn_exp2f(r_ref[q] - r_acs[q]); }
            }
            LDS_BARRIER();
            if (s + 1 < 34) { SSD_LOAD_XT_DA(0, s + 1); SSD_LOAD_XT_DA(1, s + 1); }
            if (s >= 2) {
#pragma unroll
              for (int q = 0; q < 2; ++q) {
                const int c_ = q == 0 ? s - 2 : 33 - s;
                f32x4 accD[4];
#pragma unroll
                for (int pb = 0; pb < 4; ++pb) accD[pb] = (f32x4){0.f, 0.f, 0.f, 0.f};
                int i_l = wid * 16 + fr; asm volatile("" : "+v"(i_l)); const int i = i_l;
                const float acs_i = *(const LAS float*)(a_ai + q * 2048);
                const float ei = __builtin_amdgcn_exp2f(acs_i);
#pragma unroll
                for (int ks = 0; ks < 4; ++ks)
#pragma unroll
                    for (int pb = 0; pb < 4; ++pb) { const bf16x8 a = HBF(q, pb, ks); accD[pb] = MFMA16(a, cgf[q][ks], accD[pb]); }
#pragma unroll
                for (int pb = 0; pb < 4; ++pb) accD[pb] *= ei;
                const int ksd = wid >> 1;
#pragma unroll
                for (int ks = 0; ks < 4; ++ks) {
                    if (q == 0 ? (ks < ksd) : (ks > ksd)) {
                        const float R = *(const LAS float*)(a_sc + (q * 2048 + 512 + (q == 0 ? 32 * ks + 31 : 32 * ks) * 4));
                        const float rowf = __builtin_amdgcn_exp2f(acs_i - R);
                        const f32x4 c0 = SCV(q, 3, ks, 0), c1 = SCV(q, 3, ks, 1);
                        float gv[8]; unpack8(__builtin_bit_cast(u32x4, gt[q][ks]), gv); float mv[8];
#pragma unroll
                        for (int e = 0; e < 4; ++e) { mv[e] = gv[e] * (c0[e] * rowf); mv[4 + e] = gv[4 + e] * (c1[e] * rowf); }
                        const bf16x8 mf = __builtin_bit_cast(bf16x8, pack8(mv));
#pragma unroll
                        for (int pb = 0; pb < 4; ++pb) { const bf16x8 a = XTF(q, pb, ks); accD[pb] = MFMA16(a, mf, accD[pb]); }
                    } else if (ks == ksd) {
                        const int j0 = ks * 32 + fq * 8;
                        const f32x4 a0 = SCV(q, 1, ks, 0), a1 = SCV(q, 1, ks, 1), d0 = SCV(q, 0, ks, 0), d1 = SCV(q, 0, ks, 1);
                        float gv[8]; unpack8(__builtin_bit_cast(u32x4, gt[q][ks]), gv); float mv[8];
#pragma unroll
                        for (int e = 0; e < 8; ++e) { const int j = j0 + e; const float aj = e < 4 ? a0[e & 3] : a1[e & 3], dj = e < 4 ? d0[e & 3] : d1[e & 3];
                            const bool valid = q == 0 ? (j <= i) : (j >= i);
                            float val = gv[e] * __builtin_amdgcn_exp2f(acs_i - aj) * dj; if (q == 0 && j == i) val += dsk;
                            mv[e] = valid ? val : 0.f; }
                        const bf16x8 mf = __builtin_bit_cast(bf16x8, pack8(mv));
#pragma unroll
                        for (int pb = 0; pb < 4; ++pb) { const bf16x8 a = XTF(q, pb, ks); accD[pb] = MFMA16(a, mf, accD[pb]); }
                    }
                }
                unsigned yo = (unsigned)(q == 0 ? WS_YF : WS_YB) + ((unsigned)(bl * 4096 + c_ * 128) * 2048u + h * 64) * 2u; UNI(yo);
                unsigned char* yrow = (unsigned char*)ws + yo + LN_Y();
#pragma unroll
                for (int pb = 0; pb < 4; ++pb) { u32x2 pk; pk.x = cvt_pk_bf16(accD[pb][0], accD[pb][1]); pk.y = cvt_pk_bf16(accD[pb][2], accD[pb][3]);
                    *(GAS u32x2*)(yrow + pb * 32) = pk; }
                if (s + 1 < 34) SSD_LOAD_GT_CG(q, s + 1);
              }
            } else if (s + 1 >= 2) { SSD_LOAD_GT_CG(0, s + 1); SSD_LOAD_GT_CG(1, s + 1); }
#pragma unroll
            for (int q = 0; q < 2; ++q) {
                const float dec = __builtin_amdgcn_exp2f(alast[q]);
#pragma unroll
                for (int pb = 0; pb < 4; ++pb) accH[q][pb] *= dec;
#pragma unroll
                for (int ks = 0; ks < 4; ++ks) {
                    const f32x4 w0 = SCV(q, 2, ks, 0), w1 = SCV(q, 2, ks, 1);
                    float bv[8]; unpack8(__builtin_bit_cast(u32x4, bt[q][ks]), bv);
#pragma unroll
                    for (int e = 0; e < 4; ++e) { bv[e] *= w0[e]; bv[4 + e] *= w1[e]; }
                    const bf16x8 bw = __builtin_bit_cast(bf16x8, pack8(bv));
#pragma unroll
                    for (int pb = 0; pb < 4; ++pb) { const bf16x8 xf = XTF(q, pb, ks); accH[q][pb] = MFMA16(bw, xf, accH[q][pb]); } }
                if (s + 1 < 34) SSD_LOAD_BT(q, s + 1);
            }
            LDS_BARRIER();
        }
#undef SSD_LOAD_XT_DA
#undef SSD_LOAD_BT
#undef SSD_LOAD_GT_CG
#undef UNI
#undef LN_DA
#undef LN_Y
#undef XTF
#undef HBF
#undef SCV
    }
}

#define RLX_AGENT __ATOMIC_RELAXED, __HIP_MEMORY_SCOPE_AGENT
#define XB_TMO      128
#define XB_XCNT(j)  (256  + 64 * (j))
#define XB_XSUB(j)  (1280 + 64 * (j))
#define XB_XGEN(j)  (2304 + 64 * (j))
#define XB_TOP      3328
#define XB_TOPGEN   3392
#define XCD_BAR_WORDS 3456
#define XB_SPIN_CAP (1u << 18)

__device__ __forceinline__ unsigned xb_ld(unsigned* p)              { return __hip_atomic_load(p, __ATOMIC_RELAXED, __HIP_MEMORY_SCOPE_AGENT); }
__device__ __forceinline__ unsigned xb_add(unsigned* p, unsigned v) { return __hip_atomic_fetch_add(p, v, __ATOMIC_RELAXED, __HIP_MEMORY_SCOPE_AGENT); }
__device__ __forceinline__ unsigned xb_xcc_id() { return (unsigned)__builtin_amdgcn_s_getreg((3 << 11) | 20) & 0xFu; }
#define XB_SPIN(cond, bar) do { unsigned _sp = 0; while (cond) { __builtin_amdgcn_s_sleep(1); \
    if ((++_sp & 255u) == 0u) { if (xb_ld(&(bar)[XB_TMO])) break; if (_sp > XB_SPIN_CAP) { atomicAdd(&(bar)[XB_TMO], 1u); break; } } } } while (0)

struct XcdBarrier {
    unsigned* bar; unsigned x;
    volatile LAS unsigned* st;
};

__device__ __forceinline__ XcdBarrier xcd_barrier_post(unsigned* bar, volatile LAS unsigned* st) {
    XcdBarrier b; b.bar = bar; b.x = xb_xcc_id(); b.st = st;
    if (threadIdx.x == 0) (void)xb_add(&bar[XB_XCNT(b.x)], 1u);
    return b;
}
__device__ __forceinline__ void xcd_barrier_complete(unsigned* bar, unsigned x, unsigned& nloc, unsigned& nx) {
    const unsigned G = gridDim.x * gridDim.y * gridDim.z;
    unsigned sum, cnt, mine, sp = 0u;
    for (;;) {
        sum = 0u; cnt = 0u; mine = 0u;
#pragma unroll
        for (unsigned j = 0; j < 16; ++j) { const unsigned c = xb_ld(&bar[XB_XCNT(j)]); sum += c; cnt += (c > 0u) ? 1u : 0u; mine = (j == x) ? c : mine; }
        if (sum == G) break;
        __builtin_amdgcn_s_sleep(1);
        if ((++sp & 255u) == 0u) { if (xb_ld(&bar[XB_TMO])) break; if (sp > XB_SPIN_CAP) { atomicAdd(&bar[XB_TMO], 1u); break; } }
    }
    nloc = mine > 0u ? mine : 1u; nx = cnt > 0u ? cnt : 1u;
}

__device__ __forceinline__ void xcd_barrier(const XcdBarrier& b, bool leader) {
    asm volatile("s_waitcnt vmcnt(0)" ::: "memory");
    __syncthreads();
    if (leader) {
        unsigned* bar = b.bar;
        __builtin_amdgcn_s_waitcnt(0);
        unsigned nloc = b.st[0], nx = b.st[1];
        if (nloc == 0u) { xcd_barrier_complete(bar, b.x, nloc, nx); b.st[0] = nloc; b.st[1] = nx; }
        const unsigned old = xb_add(&bar[XB_XSUB(b.x)], 1u);
        const unsigned gen = old / nloc;
        if (old + 1u == (gen + 1u) * nloc) {
            __builtin_amdgcn_fence(__ATOMIC_RELEASE, "agent");
            asm volatile("s_waitcnt vmcnt(0)" ::: "memory");
            const unsigned og = xb_add(&bar[XB_TOP], 1u);
            const unsigned tg = og / nx;
            if (og + 1u == (tg + 1u) * nx) xb_add(&bar[XB_TOPGEN], 1u);
            else XB_SPIN(xb_ld(&bar[XB_TOPGEN]) == tg, bar);
            __builtin_amdgcn_fence(__ATOMIC_ACQUIRE, "agent");
            xb_add(&bar[XB_XGEN(b.x)], 1u);
            asm volatile("s_waitcnt vmcnt(0)" ::: "memory");
        } else {
            XB_SPIN(xb_ld(&bar[XB_XGEN(b.x)]) == gen, bar);
            __builtin_amdgcn_fence(__ATOMIC_ACQUIRE, "agent");
            asm volatile("s_waitcnt vmcnt(0)" ::: "memory");
        }
    }
    __syncthreads();
}

struct Args { const float* in[21]; float* out; unsigned char* ws; int ph_lo, ph_hi; };
static_assert(sizeof(Args) == 23 * 8 + 8, "Args has no padding");


#if defined(__HIP_DEVICE_COMPILE__)
#define ASSUME_GLOBAL(p_) __builtin_assume(!__builtin_amdgcn_is_shared(p_) && !__builtin_amdgcn_is_private(p_))
#else
#define ASSUME_GLOBAL(p_) ((void)0)
#endif
#define IN_(k) (args.in[k])
#define x_in IN_(0)
#define c_in IN_(1)
#define ctx IN_(2)
#define c_ctx IN_(3)
#define w_ada IN_(4)
#define b_ada IN_(5)
#define norm_pre IN_(6)
#define norm_post IN_(7)
#define w_in IN_(8)
#define b_merge IN_(9)
#define pool_w IN_(10)
#define pool_scale IN_(11)
#define conv_w IN_(12)
#define conv_b IN_(13)
#define dt_bias IN_(14)
#define a_log IN_(15)
#define d_skip IN_(16)
#define ssd_norm IN_(17)
#define w_proj_pool IN_(18)
#define w_proj_ssd IN_(19)
#define w_out IN_(20)
#define out_p (args.out)
#define WSB(off) ((bf16_t*)(ws_l + (off)))
#define WSF(off) ((float*)(ws_l + (off)))
#define WIN WSB(WS_WIN)
#define WPP WSB(WS_WPP)
#define WPS WSB(WS_WPS)
#define WO WSB(WS_WO)
#define PW WSB(WS_PW)
#define MOD WSF(WS_MOD)
#define HC WSB(WS_HC)
#define CXBC WSB(WS_CXBC)
#define CXT WSB(WS_CXT)
#define CBT WSB(WS_CBT)
#define CDT WSF(WS_CDT)
#define CDTV WSF(WS_CDTV)
#define CACS WSF(WS_CACS)
#define HX WSB(WS_HX)
#define V WSB(WS_V)
#define SZS WSB(WS_SZS)
#define GATES WSB(WS_GATES)
#define XBC WSB(WS_XBC)
#define DTR WSF(WS_DTR)
#define DTV WSF(WS_DTV)
#define ACS WSF(WS_ACS)
#define XT WSB(WS_XT)
#define CG WSB(WS_CG)
#define BT WSB(WS_BT)
#define GT WSB(WS_GT)
#define YF WSB(WS_YF)
#define YP WSB(WS_YP)
#define YB WSB(WS_YB)
#define MRG WSB(WS_MRG)
__global__ void __launch_bounds__(NTHR, 2) fwd_megakernel(Args args) {
    extern __shared__ __attribute__((aligned(16))) unsigned char lds_raw[];
    cg::grid_group grid = cg::this_grid();
    LAS unsigned char* lds = (LAS unsigned char*)lds_raw;
#pragma unroll
    for (int k_ = 0; k_ < 21; ++k_) ASSUME_GLOBAL(args.in[k_]);
    ASSUME_GLOBAL(args.out);
    grid.sync();
    { volatile LAS unsigned* st0 = (volatile LAS unsigned*)(lds + LDS_BYTES - 64); if (threadIdx.x < 16) st0[threadIdx.x] = 0u; }
    __syncthreads();
    const XcdBarrier bar = xcd_barrier_post((unsigned*)(GAS unsigned*)(args.ws + WS_BAR), (volatile LAS unsigned*)(lds + LDS_BYTES - 64));
    const int G = gridDim.x, bx = blockIdx.x, NGW = G * 8, wave_k = __builtin_amdgcn_readfirstlane((int)threadIdx.x >> 6);
    const int lo = args.ph_lo, hi = args.ph_hi;
    int ph = 0;
#ifndef PROBE_MASK
#define PROBE_MASK 0
#endif
#define PHASE_BEGIN(id_) if (lo <= ph && ph < hi) { for (int rep_ = 0; rep_ <= ((PROBE_MASK >> (id_)) & 1); ++rep_) { if (rep_) __syncthreads(); int tid_l = wave_k * 64 + fresh_lane(); asm volatile("" : "+v"(tid_l)); const int tid = tid_l, lane = tid & 63, wave = wave_k; \
        int vcu_l = (G % 8 == 0) ? (bx % 8) * (G / 8) + bx / 8 : bx; asm volatile("" : "+s"(vcu_l)); const int vcu = vcu_l, gw = vcu * 8 + wave; (void)tid; (void)lane; (void)gw; \
        unsigned char* ws_l = args.ws; asm volatile("" : "+s"(ws_l)); ASSUME_GLOBAL(ws_l);
#define PHASE_END } } ++ph; if (lo < ph && ph < hi) xcd_barrier(bar, wave_k == 0 && fresh_lane() == 0);

    PHASE_BEGIN(0)
        for (int it = vcu; it < 48; it += G) mod_item(lds, c_in, c_ctx, w_ada, b_ada, MOD, it, tid);
        LAS float* scr = (LAS float*)(lds + wave * 16384);
        constexpr int I_IN = 16 * 290, I_PP = 16 * 32, I_PS = 32 * 32, I_O = 16 * 32, I_PW = 4 * 8;
        for (int it = gw; it < I_IN + I_PP + I_PS + I_O + 4 * I_PW; it += NGW) {
            int r = it;
            if (r < I_IN) { transpose_item(w_in, 1024, 9280, WIN, 1024, 0, scr, r, lane); continue; } r -= I_IN;
            if (r < I_PP) { transpose_item(w_proj_pool, 1024, 1024, WPP, 1024, 0, scr, r, lane); continue; } r -= I_PP;
            if (r < I_PS) { transpose_item(w_proj_ssd, 2048, 1024, WPS, 2048, 0, scr, r, lane); continue; } r -= I_PS;
            if (r < I_O) { transpose_item(w_out, 1024, 1024, WO, 1024, 0, scr, r, lane); continue; } r -= I_O;
            { const int gq = r / I_PW; transpose_item(pool_w + (size_t)gq * 65536, 256, 256, PW, 256, gq * 256, scr, r % I_PW, lane); }
        }
    PHASE_END
    PHASE_BEGIN(1)
        for (int m = gw; m < CT; m += NGW) modnorm_row(ctx + (size_t)m * 1024, norm_pre, MOD + 16 * 3072, HC + (size_t)m * 1024, lane);
        for (int m = gw; m < T; m += NGW) modnorm_row(x_in + (size_t)m * 1024, norm_pre, MOD + (m >> 12) * 3072, HX + (size_t)m * 1024, lane);
    PHASE_END
    for (int grp = 0; grp < NGRP; ++grp) {
        const int b0 = grp * NB; const size_t tok0 = (size_t)b0 * SEQ;
        float* outg = out_p + tok0 * 1024;
        bf16_t* SZP = (bf16_t*)outg; bf16_t* DD = (bf16_t*)outg + (size_t)T * 1024;
        PHASE_BEGIN(2)
            if (grp == 0) {
                pg8::Gemm g{HC, WIN + (size_t)24 * 256 * 1024, 1024, 1024, 1024, 0}; pg8::StaticOrder S; S.init(CT, 13 * 256, G, bx);
                EpiInProj E{nullptr, nullptr, nullptr, nullptr, CXBC, CDT, b_merge, 24};
                pg8::gemm_phase<EpiInProj, pg8::StaticOrder, true, true>(lds, g, S, E, tid);
            }
            { pg8::Gemm g{HX, WIN, 1024, 1024, 1024, 0}; pg8::StaticOrder S; S.init(T, INP, G, bx);
              EpiInProj E{V, SZP, SZS, GATES, XBC, DTR, b_merge, 0};
              pg8::gemm_phase<EpiInProj, pg8::StaticOrder, true, true>(lds, g, S, E, tid); }
        PHASE_END
        PHASE_BEGIN(3)
            if (grp == 0) {
                for (int it = vcu; it < 16 * 2 * 4; it += G) { const int g = it & 3, cc = (it >> 2) & 1, b = it >> 3;
                    conv_bc_item(lds, CXBC + (size_t)b * CTXL * 3072, CTXL, cc, g, CBT + ((size_t)((b * 2 + cc) * 512 + g * 128)) * 128, nullptr, nullptr, conv_w, conv_b, tid); }
                for (int it = vcu; it < 16 * 2; it += G) { const int cc = it & 1, b = it >> 1;
                    dt_item(lds, CDT + (size_t)b * CTXL * 64, CTXL, cc, CDTV + (size_t)b * 32 * CTXL, CACS + (size_t)b * 32 * CTXL, (size_t)16 * 32 * CTXL, dt_bias, a_log, tid); }
            }
            for (int it = vcu; it < NB * 32 * 4; it += G) { const int g = it & 3, cc = (it >> 2) & 31, b = it >> 7;
                conv_bc_item(lds, XBC + (size_t)b * SEQ * 3072, SEQ, cc, g, BT + ((size_t)((b * 32 + cc) * 512 + g * 128)) * 128, CG + ((size_t)(((b * 32 + cc) * 4 + g) * 128)) * 128,
                             GT + ((size_t)(((b * 32 + cc) * 4 + g) * 128)) * 128, conv_w, conv_b, tid); }
            for (int it = vcu; it < NB * 32; it += G) { const int cc = it & 31, b = it >> 5;
                dt_item(lds, DTR + (size_t)b * SEQ * 64, SEQ, cc, DTV + (size_t)b * 32 * SEQ, ACS + (size_t)b * 32 * SEQ, (size_t)NB * 32 * SEQ, dt_bias, a_log, tid); }
            { LAS unsigned char* wl = lds + wave * (64 * RS);
              if (grp == 0) for (int it = gw; it < 16 * 2 * 32; it += NGW) { const int hb = it & 31, cc = (it >> 5) & 1, b = it >> 6;
                    conv_xs_wave(wl, CXBC + (size_t)b * CTXL * 3072, CTXL, cc, hb, CXT + ((size_t)((b * 2 + cc) * 2048 + hb * 64)) * 128, conv_w, conv_b, lane); }
              for (int it = gw; it < NB * 32 * 32; it += NGW) { const int hb = it & 31, cc = (it >> 5) & 31, b = it >> 10;
                    conv_xs_wave(wl, XBC + (size_t)b * SEQ * 3072, SEQ, cc, hb, XT + ((size_t)((b * 32 + cc) * 2048 + hb * 64)) * 128, conv_w, conv_b, lane); }
              for (int it = gw; it < NB * 64 * 16; it += NGW) { const int cq = it & 3, gi = (it >> 2) & 3, r = (it >> 4) & 63, b = it >> 10;
                    pool_wave(wl, V + (size_t)b * SEQ * 1024, DD + (size_t)b * SEQ * 1024, r, gi, cq, lane); } }
        PHASE_END
        PHASE_BEGIN(4)
            ssd_phase(lds, ws_l, d_skip, b0, vcu, G, tid);
        PHASE_END
        PHASE_BEGIN(5)
            for (int it = gw; it < T * 4; it += NGW) { const int gq = it & 3; const size_t m = (size_t)(it >> 2);
                gnorm_item(YF + m * 2048 + gq * 512, YB + m * 2048 + gq * 512, SZS + m * 2048 + gq * 512, ssd_norm + gq * 512, lane); }
            asm volatile("s_waitcnt vmcnt(0)" ::: "memory"); __syncthreads();
            { pg8::Gemm g{DD, PW, 1024, 256, 256, 256}; pg8::StaticOrder S; S.init(T, 1024, G, bx);
              EpiPool E{YP, SZP, pool_scale};
              pg8::gemm_phase<EpiPool, pg8::StaticOrder, true, true>(lds, g, S, E, tid); }
        PHASE_END
        PHASE_BEGIN(6)
            { pg8::Gemm g{YP, WPP, 1024, 1024, 1024, 0}; pg8::StaticOrder S; S.init(T, 1024, G, bx);
              EpiM1 E{outg, GATES};
              pg8::gemm_phase<EpiM1, pg8::StaticOrder, true, true>(lds, g, S, E, tid); }
            asm volatile("s_waitcnt vmcnt(0)" ::: "memory"); __syncthreads();
            { pg8::Gemm g{YF, WPS, 2048, 2048, 2048, 0}; pg8::StaticOrder S; S.init(T, 1024, G, bx);
              EpiM2 E{outg, GATES, MRG};
              pg8::gemm_phase<EpiM2, pg8::StaticOrder, true, true>(lds, g, S, E, tid); }
        PHASE_END
        PHASE_BEGIN(7)
            { pg8::Gemm g{MRG, WO, 1024, 1024, 1024, 0}; pg8::StaticOrder S; S.init(T, 1024, G, bx);
              EpiF32 E{outg};
              pg8::gemm_phase<EpiF32, pg8::StaticOrder, true, true>(lds, g, S, E, tid); }
        PHASE_END
        PHASE_BEGIN(8)
            for (int m = gw; m < T; m += NGW) { const size_t row = tok0 + m; final_row(out_p + row * 1024, x_in + row * 1024, norm_post, MOD + (row >> 12) * 3072 + 2048, lane); }
            if (grp + 1 < NGRP) for (int m = gw; m < T; m += NGW) { const size_t row = tok0 + T + m; modnorm_row(x_in + row * 1024, norm_pre, MOD + (row >> 12) * 3072, HX + (size_t)m * 1024, lane); }
        PHASE_END
    }
#undef PHASE_BEGIN
#undef PHASE_END
}

#undef x_in
#undef c_in
#undef ctx
#undef c_ctx
#undef w_ada
#undef b_ada
#undef norm_pre
#undef norm_post
#undef w_in
#undef b_merge
#undef pool_w
#undef pool_scale
#undef conv_w
#undef conv_b
#undef dt_bias
#undef a_log
#undef d_skip
#undef ssd_norm
#undef w_proj_pool
#undef w_proj_ssd
#undef w_out
#undef out_p
#undef WIN
#undef WPP
#undef WPS
#undef WO
#undef PW
#undef MOD
#undef HC
#undef CXBC
#undef CXT
#undef CBT
#undef CDT
#undef CDTV
#undef CACS
#undef HX
#undef V
#undef SZS
#undef GATES
#undef XBC
#undef DTR
#undef DTV
#undef ACS
#undef XT
#undef CG
#undef BT
#undef GT
#undef YF
#undef YP
#undef YB
#undef MRG
extern "C" void kernel_launch(void* const* d_in, const int* in_sizes, int n_in, void* d_out, int out_size, void* d_ws, size_t ws_size, hipStream_t stream) {
    static int grid = 0;
    if (grid == 0) {
        int dev = 0, cus = 0, per_cu = 0;
        (void)hipGetDevice(&dev); (void)hipDeviceGetAttribute(&cus, hipDeviceAttributeMultiprocessorCount, dev);
        (void)hipFuncSetAttribute((const void*)fwd_megakernel, hipFuncAttributeMaxDynamicSharedMemorySize, LDS_BYTES);
        (void)hipOccupancyMaxActiveBlocksPerMultiprocessor(&per_cu, (const void*)fwd_megakernel, NTHR, LDS_BYTES);
        if (per_cu < 1) per_cu = 1;
        grid = cus * per_cu;
        if (n_in != 21 || ws_size < WS_END) { fprintf(stderr, "kernel_launch: unexpected n_in %d / ws %zu\n", n_in, ws_size); }
        (void)hipGetLastError();
    }
    (void)hipMemsetAsync((char*)d_ws + WS_BAR, 0, 16384, stream);
    Args a{};
    for (int i = 0; i < 21; ++i) a.in[i] = (const float*)d_in[i];
    a.out = (float*)d_out; a.ws = (unsigned char*)d_ws; a.ph_lo = 0; a.ph_hi = 1 << 20;
    void* kargs[] = {&a};
    hipError_t e = hipLaunchCooperativeKernel((const void*)fwd_megakernel, dim3(grid), dim3(NTHR), kargs, LDS_BYTES, stream);
    if (e != hipSuccess) fprintf(stderr, "cooperative launch failed: %s (grid %d)\n", hipGetErrorString(e), grid);
}
```

```cpp
#include <hip/hip_runtime.h>
#include <hip/hip_cooperative_groups.h>
#include <cstdio>
#include <cstdint>
namespace cg = cooperative_groups;
namespace pg8 {
#define PG8_LAS __attribute__((address_space(3)))
typedef unsigned short bf16_t;
typedef short bf16x8 __attribute__((ext_vector_type(8)));
typedef float f32x4 __attribute__((ext_vector_type(4)));
typedef unsigned u32x4 __attribute__((ext_vector_type(4)));
constexpr int BM = 256, BK = 64, HALF = 128, HTB = HALF * BK * 2  , STAGE_BYTES = 8 * HTB, NXCD = 8, WGM = 8;

__host__ __device__ __forceinline__ int lds_byte(int r, int c) { const int st = (r >> 4) * 2 + (c >> 5), rr = r & 15, cc = c & 31, ob = rr * 64 + cc * 2; return st * 1024 + (ob ^ (((ob >> 9) & 1) << 5)); }
__host__ __device__ __forceinline__ void stage_rc(int b, int& R, int& C) { const int st = b / 1024, sb = b % 1024, swz = sb ^ (((sb >> 9) & 1) << 5); R = (st >> 1) * 16 + swz / 64; C = (st & 1) * 32 + (swz % 64) / 2; }
__host__ __device__ __forceinline__ int perm32(int rho) { const int n = rho >> 4, i = rho & 15; return 8 * (i >> 2) + 4 * n + (i & 3); }

struct Unit { int pm, pn; };
struct Gemm { const bf16_t* A; const bf16_t* Bt; int lda, ldb, K, a_pn_off; };
struct StaticOrder {
    int nM, nN, nwg, G, c;
    __host__ __device__ void init(int M, int N, int G_, int c_) { nM = M / BM; nN = N / BM; nwg = nM * nN; G = G_; c = c_; }
    __host__ __device__ bool next(int i, Unit& u) const {
        const long L = (long)i * G + c; if (L >= nwg) return false;
        int wgid = (int)L; { const int q = nwg / NXCD, r = nwg % NXCD, xcd = wgid % NXCD, off = wgid / NXCD; wgid = (xcd < r ? xcd * (q + 1) : r * (q + 1) + (xcd - r) * q) + off; }
        const int nig = WGM * nN, gid = wgid / nig, fm = gid * WGM, gsz = (nM - fm) < WGM ? (nM - fm) : WGM;
        u.pm = fm + ((wgid % nig) % gsz); u.pn = (wgid % nig) / gsz; return true;
    }
    __device__ __forceinline__ void a_ready(const Unit&) const {}
    __device__ __forceinline__ void done(const Unit&) const {}
};
typedef float f32x2_cv __attribute__((ext_vector_type(2)));
typedef __bf16 bf16x2_cv __attribute__((ext_vector_type(2)));
__device__ __forceinline__ unsigned cvt_pk_bf16(float lo, float hi) { const f32x2_cv v = {lo, hi}; const bf16x2_cv b = __builtin_convertvector(v, bf16x2_cv); return __builtin_bit_cast(unsigned, b); }
template <class Epi, class Sched, bool ALIGN_EPI = false, bool SP2 = false>
__device__ __forceinline__ void gemm_phase(PG8_LAS unsigned char* lds, const Gemm g, const Sched& S, const Epi& E, int tid_in) {
    int tid_l = tid_in; asm volatile("" : "+v"(tid_l));
    const int tid = tid_l, wid = __builtin_amdgcn_readfirstlane(tid >> 6), lane = tid & 63, wr = wid >> 2, wc = wid & 3, fr = lane & 15, fq = lane >> 4;
    const int K = g.K, nt = K / BK;
    unsigned voffA[2], voffB[2];
#pragma unroll
    for (int i = 0; i < 2; ++i) { int R, C; stage_rc(tid * 16 + i * 8192, R, C); const int Rb = Epi::PERM ? ((R & ~31) + perm32(R & 31)) : R;
        voffA[i] = (unsigned)(R * g.lda + C) * 2u; voffB[i] = (unsigned)(Rb * g.ldb + C) * 2u; }
    const size_t kstep = (size_t)(BK * 2);
    const size_t hstepA = (size_t)HALF * g.lda * 2, hstepB = (size_t)HALF * g.ldb * 2;
    const size_t tstepA = 2 * hstepA, tstepB = 2 * hstepB, pnoffA = (size_t)g.a_pn_off * 2;
    const unsigned ldsw = (unsigned)wid * 1024u;
    const int aoff = lds_byte(wr * 64 + fr, fq * 8), boff = lds_byte(wc * 32 + fr, fq * 8);
#define PG8_SA(b, h) (((b) * 2 + (h)) * HTB)
#define PG8_SB(b, h) ((4 + (b) * 2 + (h)) * HTB)
#define PG8_STAGE(bufoff, gbase, voff) do { _Pragma("unroll") for (int _i = 0; _i < 2; ++_i) \
        __builtin_amdgcn_global_load_lds((const unsigned*)((const char*)(gbase) + (voff)[_i]), (PG8_LAS unsigned*)(lds + (bufoff) + ldsw + _i * 8192), 16, 0, 0); } while (0)
#define PG8_LDA(dst, b, h) do { _Pragma("unroll") for (int m = 0; m < 4; ++m) _Pragma("unroll") for (int k = 0; k < 2; ++k) dst[m][k] = *(const PG8_LAS bf16x8*)(lds + PG8_SA(b, h) + aoff + m * 2048 + k * 1024); } while (0)
#define PG8_LDB(dst, b, h) do { _Pragma("unroll") for (int n = 0; n < 2; ++n) _Pragma("unroll") for (int k = 0; k < 2; ++k) dst[n][k] = *(const PG8_LAS bf16x8*)(lds + PG8_SB(b, h) + boff + n * 2048 + k * 1024); } while (0)
#define PG8_MMA(ai, bj, At, Bt) do { __builtin_amdgcn_s_setprio(1); _Pragma("unroll") for (int m = 0; m < 4; ++m) _Pragma("unroll") for (int n = 0; n < 2; ++n) _Pragma("unroll") for (int k = 0; k < 2; ++k) \
        acc[ai][bj][m][n] = __builtin_amdgcn_mfma_f32_16x16x32_bf16(Bt[n][k], At[m][k], acc[ai][bj][m][n], 0, 0, 0); __builtin_amdgcn_s_setprio(0); } while (0)
#define PG8_WAIT_V(n) asm volatile("s_waitcnt vmcnt(" #n ")" ::: "memory")
#define PG8_WAIT_L(n) asm volatile("s_waitcnt lgkmcnt(" #n ")" ::: "memory")
#define PG8_BAR __builtin_amdgcn_s_barrier()
#define PG8_SCHED __builtin_amdgcn_sched_barrier(0)
    Unit cur, nxt; int ui = 0;
    if (!S.next(0, cur)) return;
    f32x4 acc[2][2][4][2];
#pragma unroll
    for (int a = 0; a < 2; ++a)
#pragma unroll
        for (int b = 0; b < 2; ++b)
#pragma unroll
            for (int m = 0; m < 4; ++m)
#pragma unroll
                for (int n = 0; n < 2; ++n) acc[a][b][m][n] = (f32x4){0.f, 0.f, 0.f, 0.f};
    bf16x8 At[4][2], B0[2][2], B1[2][2];
    const char* cA = (const char*)g.A + (size_t)cur.pm * tstepA + (size_t)cur.pn * pnoffA; const char* cB = (const char*)g.Bt + (size_t)cur.pn * tstepB;
    S.a_ready(cur);
    if constexpr (SP2) {
        PG8_STAGE(PG8_SB(0, 0), cB, voffB); PG8_STAGE(PG8_SB(0, 1), cB + hstepB, voffB); PG8_STAGE(PG8_SA(0, 0), cA, voffA); PG8_STAGE(PG8_SA(0, 1), cA + hstepA, voffA);
        if (wr == 1) PG8_BAR;
        PG8_WAIT_V(2); PG8_BAR;
        PG8_STAGE(PG8_SB(1, 0), cB + kstep, voffB); PG8_STAGE(PG8_SA(1, 0), cA + kstep, voffA); PG8_STAGE(PG8_SB(1, 1), cB + hstepB + kstep, voffB);
        PG8_WAIT_V(6); PG8_BAR;
    } else {
        PG8_STAGE(PG8_SB(0, 0), cB, voffB); PG8_STAGE(PG8_SA(0, 0), cA, voffA); PG8_STAGE(PG8_SB(0, 1), cB + hstepB, voffB); PG8_STAGE(PG8_SA(0, 1), cA + hstepA, voffA);
        if (wr == 1) PG8_BAR;
        PG8_WAIT_V(4); PG8_BAR;
        PG8_STAGE(PG8_SB(1, 0), cB + kstep, voffB); PG8_STAGE(PG8_SA(1, 0), cA + kstep, voffA); PG8_STAGE(PG8_SB(1, 1), cB + hstepB + kstep, voffB);
        PG8_WAIT_V(6); PG8_BAR;
    }
    for (;;) {
        const bool has_next = S.next(ui + 1, nxt);
        const char* nA = has_next ? (const char*)g.A + (size_t)nxt.pm * tstepA + (size_t)nxt.pn * pnoffA : cA; const char* nB = has_next ? (const char*)g.Bt + (size_t)nxt.pn * tstepB : cB;
        for (int t = 0; t < nt; t += 2) {
            const bool last = (t == nt - 2);
            const char* a1 = cA + (size_t)(t + 1) * kstep;
            const char* a2 = last ? nA : cA + (size_t)(t + 2) * kstep; const char* b2 = last ? nB : cB + (size_t)(t + 2) * kstep;
            const char* a3 = a2 + kstep; const char* b3 = b2 + kstep;
            if (last && has_next) S.a_ready(nxt);
            if constexpr (SP2) {
            PG8_LDB(B0, 0, 0); PG8_LDB(B1, 0, 1); PG8_SCHED; PG8_LDA(At, 0, 0); PG8_STAGE(PG8_SA(1, 1), a1 + hstepA, voffA);
            PG8_WAIT_V(8); PG8_WAIT_L(0); PG8_BAR; PG8_MMA(0, 0, At, B0); PG8_MMA(0, 1, At, B1); PG8_BAR; PG8_SCHED;
            PG8_LDA(At, 0, 1); PG8_STAGE(PG8_SB(0, 0), b2, voffB); PG8_STAGE(PG8_SB(0, 1), b2 + hstepB, voffB); PG8_STAGE(PG8_SA(0, 0), a2, voffA);
            PG8_WAIT_V(8); PG8_WAIT_L(0); PG8_BAR; PG8_MMA(1, 0, At, B0); PG8_MMA(1, 1, At, B1); PG8_BAR; PG8_SCHED;
            PG8_LDB(B0, 1, 0); PG8_LDB(B1, 1, 1); PG8_SCHED; PG8_LDA(At, 1, 0); PG8_STAGE(PG8_SA(0, 1), a2 + hstepA, voffA);
            PG8_WAIT_V(8); PG8_WAIT_L(0); PG8_BAR; PG8_MMA(0, 0, At, B0); PG8_MMA(0, 1, At, B1); PG8_BAR; PG8_SCHED;
            PG8_LDA(At, 1, 1); PG8_STAGE(PG8_SB(1, 0), b3, voffB); PG8_STAGE(PG8_SB(1, 1), b3 + hstepB, voffB); PG8_STAGE(PG8_SA(1, 0), a3, voffA);
            PG8_WAIT_V(8); PG8_WAIT_L(0); PG8_BAR; PG8_MMA(1, 0, At, B0); PG8_MMA(1, 1, At, B1); PG8_BAR; PG8_SCHED;
            } else {
            PG8_LDB(B0, 0, 0); PG8_SCHED; PG8_LDA(At, 0, 0); PG8_STAGE(PG8_SA(1, 1), a1 + hstepA, voffA);
            PG8_WAIT_L(8); PG8_BAR; PG8_WAIT_L(0); PG8_MMA(0, 0, At, B0); PG8_BAR; PG8_SCHED;
            PG8_LDB(B1, 0, 1); PG8_STAGE(PG8_SB(0, 0), b2, voffB);
            PG8_BAR; PG8_WAIT_L(0); PG8_MMA(0, 1, At, B1); PG8_BAR;
            PG8_LDA(At, 0, 1); PG8_STAGE(PG8_SA(0, 0), a2, voffA);
            PG8_BAR; PG8_WAIT_L(0); PG8_MMA(1, 0, At, B0); PG8_BAR; PG8_SCHED;
            PG8_STAGE(PG8_SB(0, 1), b2 + hstepB, voffB);
            PG8_WAIT_V(6); PG8_BAR; PG8_MMA(1, 1, At, B1); PG8_BAR;
            PG8_LDB(B0, 1, 0); PG8_SCHED; PG8_LDA(At, 1, 0); PG8_STAGE(PG8_SA(0, 1), a2 + hstepA, voffA);
            PG8_WAIT_L(8); PG8_BAR; PG8_WAIT_L(0); PG8_MMA(0, 0, At, B0); PG8_BAR; PG8_SCHED;
            PG8_LDB(B1, 1, 1); PG8_STAGE(PG8_SB(1, 0), b3, voffB);
            PG8_BAR; PG8_WAIT_L(0); PG8_MMA(0, 1, At, B1); PG8_BAR;
            PG8_LDA(At, 1, 1); PG8_STAGE(PG8_SA(1, 0), a3, voffA);
            PG8_BAR; PG8_WAIT_L(0); PG8_MMA(1, 0, At, B0); PG8_BAR; PG8_SCHED;
            PG8_STAGE(PG8_SB(1, 1), b3 + hstepB, voffB);
            PG8_WAIT_V(6); PG8_BAR; PG8_MMA(1, 1, At, B1); PG8_BAR;
            }
        }
        if constexpr (ALIGN_EPI) { if (wr == 0) PG8_BAR; }
        if constexpr (!Epi::AFTER_DRAIN) { E(acc, cur, wr, wc, fr, fq); S.done(cur); }
        if (!has_next) break;
#pragma unroll
        for (int a = 0; a < 2; ++a)
#pragma unroll
            for (int b = 0; b < 2; ++b)
#pragma unroll
                for (int m = 0; m < 4; ++m)
#pragma unroll
                    for (int n = 0; n < 2; ++n) acc[a][b][m][n] = (f32x4){0.f, 0.f, 0.f, 0.f};
        cur = nxt; cA = nA; cB = nB; ++ui;
        if constexpr (ALIGN_EPI) { if (wr == 1) PG8_BAR; }
    }
    PG8_WAIT_V(0);
    if constexpr (!ALIGN_EPI) { if (wr == 0) PG8_BAR; }
    PG8_BAR;
    if constexpr (Epi::AFTER_DRAIN) { E.fused(acc, cur, wr, wc, fr, fq, lds, wid, lane); S.done(cur); }
#undef PG8_SA
#undef PG8_SB
#undef PG8_STAGE
#undef PG8_LDA
#undef PG8_LDB
#undef PG8_MMA
#undef PG8_WAIT_V
#undef PG8_WAIT_L
#undef PG8_BAR
#undef PG8_SCHED
}
}
using pg8::bf16_t; using pg8::bf16x8; using pg8::f32x4; using pg8::u32x4; using pg8::cvt_pk_bf16;
#define LAS __attribute__((address_space(3)))
#define GAS __attribute__((address_space(1)))
typedef unsigned u32x2 __attribute__((ext_vector_type(2)));
#define DI __device__ __forceinline__

constexpr int D = 1024, BATCH = 16, SEQ = 4096, CTXL = 256, NH = 32;
constexpr int INP = 9472;
constexpr int NB = 8, T = NB * SEQ, NGRP = BATCH / NB, CT = BATCH * CTXL;
constexpr float EPS = 1e-6f;
constexpr int NTHR = 512;
constexpr int LDS_BYTES = 147456;

constexpr size_t MiB = 1u << 20;
constexpr size_t al256(size_t x) { return (x + 255) & ~(size_t)255; }
constexpr size_t WS_WIN = 0;
constexpr size_t WS_WPP = WS_WIN + al256((size_t)INP * 1024 * 2);
constexpr size_t WS_WPS = WS_WPP + 2 * MiB;
constexpr size_t WS_WO = WS_WPS + 4 * MiB;
constexpr size_t WS_PW = WS_WO + 2 * MiB;
constexpr size_t WS_MOD = WS_PW + MiB / 2;
constexpr size_t WS_HC = WS_MOD + al256(17 * 3072 * 4);
constexpr size_t WS_CXBC = WS_HC + (size_t)CT * 1024 * 2;
constexpr size_t WS_CDT = WS_CXBC + (size_t)CT * 3072 * 2;
constexpr size_t WS_CXT = WS_CDT + (size_t)CT * 64 * 4;
constexpr size_t WS_CBT = WS_CXT + (size_t)CT * 2048 * 2;
constexpr size_t WS_CDTV = WS_CBT + (size_t)CT * 512 * 2;
constexpr size_t WS_CACS = WS_CDTV + (size_t)2 * CT * 32 * 4;
constexpr size_t WS_HX = WS_CACS + (size_t)2 * CT * 32 * 4;
constexpr size_t WS_V = WS_HX + (size_t)T * 1024 * 2;
constexpr size_t WS_SZS = WS_V + (size_t)T * 1024 * 2;
constexpr size_t WS_GATES = WS_SZS + (size_t)T * 2048 * 2;
constexpr size_t WS_XBC = WS_GATES + (size_t)T * 2048 * 2;
constexpr size_t WS_DTR = WS_XBC + (size_t)T * 3072 * 2;
constexpr size_t WS_XT = WS_DTR + (size_t)T * 64 * 4;
constexpr size_t WS_CG = WS_XT + (size_t)T * 2048 * 2;
constexpr size_t WS_BT = WS_CG + (size_t)T * 512 * 2;
constexpr size_t WS_GT = WS_BT + (size_t)T * 512 * 2;
constexpr size_t WS_DTV = WS_GT + (size_t)T * 512 * 2;
constexpr size_t WS_ACS = WS_DTV + (size_t)2 * T * 32 * 4;
constexpr size_t WS_END = WS_ACS + (size_t)2 * T * 32 * 4;
constexpr size_t WS_BAR = al256(WS_END);
constexpr size_t WS_YF = WS_XBC, WS_YP = WS_XBC + (size_t)T * 2048 * 2, WS_YB = WS_HX, WS_MRG = WS_HX;
static_assert(WS_BAR + 16384 <= 1024 * MiB, "workspace map");

DI float bflo(unsigned w) { return __uint_as_float(w << 16); }
DI float bfhi(unsigned w) { return __uint_as_float(w & 0xffff0000u); }
DI float silu_f(float x) { return x * __builtin_amdgcn_rcpf(1.f + __expf(-x)); }
DI float silu_k(float x, float nk) { return x * __builtin_amdgcn_rcpf(1.f + __builtin_amdgcn_exp2f(x * nk)); }
DI float sigm_f(float x) { return __builtin_amdgcn_rcpf(1.f + __expf(-x)); }
DI float wave_sum(float v, int lane) {
#pragma unroll
    for (int o = 1; o < 64; o <<= 1) v += __int_as_float(__builtin_amdgcn_ds_bpermute((lane ^ o) << 2, __float_as_int(v)));
    return v;
}
DI u32x4 pack8(const float* o) { u32x4 w; w.x = cvt_pk_bf16(o[0], o[1]); w.y = cvt_pk_bf16(o[2], o[3]); w.z = cvt_pk_bf16(o[4], o[5]); w.w = cvt_pk_bf16(o[6], o[7]); return w; }
DI void unpack8(u32x4 w, float* o) { o[0] = bflo(w.x); o[1] = bfhi(w.x); o[2] = bflo(w.y); o[3] = bfhi(w.y); o[4] = bflo(w.z); o[5] = bfhi(w.z); o[6] = bflo(w.w); o[7] = bfhi(w.w); }
#define MFMA16(a, b, c) __builtin_amdgcn_mfma_f32_16x16x32_bf16((a), (b), (c), 0, 0, 0)

DI int fresh_lane() { unsigned m = ~0u; asm volatile("" : "+s"(m)); int l = (int)__builtin_amdgcn_mbcnt_hi(m, __builtin_amdgcn_mbcnt_lo(m, 0u)); asm volatile("" : "+v"(l)); return l; }
constexpr int EPI_PATCH_OFF = 131072, EPI_PATCH_BYTES = 1280;
DI void wave_store_rows(unsigned patch, int ln, u32x4 w, unsigned char* gbase, size_t row_stride_bytes) {
    *(LAS u32x4*)(patch + (ln & 15) * 80 + (ln >> 4) * 16) = w;
    asm volatile("s_waitcnt lgkmcnt(0)" ::: "memory");
    const u32x4 r = *(const LAS u32x4*)(patch + (ln >> 2) * 80 + (ln & 3) * 16);
    *(GAS u32x4*)(gbase + (size_t)(ln >> 2) * row_stride_bytes + (ln & 3) * 16) = r;
    asm volatile("" ::: "memory");
}
struct EpiInProj {
    static constexpr bool PERM = true, AFTER_DRAIN = false;
    bf16_t *V, *SZP, *SZS, *GATES, *XBC; float* DT; const float* b_merge; int pn_base; unsigned patch0;
    __device__ __forceinline__ void operator()(const f32x4 (&acc)[2][2][4][2], const pg8::Unit& u, int wr, int wc, int, int) const { const int ln_ = fresh_lane(), fr = ln_ & 15, fq = ln_ >> 4;
        const int pn = u.pn + pn_base; int mode, ldc, colt; bf16_t* O;
        if (pn < 4) { mode = 0; O = V; ldc = 1024; colt = pn * 256; }
        else if (pn < 8) { mode = 1; O = SZP; ldc = 1024; colt = (pn - 4) * 256; }
        else if (pn < 16) { mode = 1; O = SZS; ldc = 2048; colt = (pn - 8) * 256; }
        else if (pn < 24) { mode = 2; O = GATES; ldc = 2048; colt = (pn - 16) * 256; }
        else if (pn < 36) { mode = 0; O = XBC; ldc = 3072; colt = (pn - 24) * 256; }
        else { mode = 3; O = nullptr; ldc = 64; colt = 0; }
        const int row0 = u.pm * 256 + wr * 64 + fr;
        if (mode == 3) {
            if (wc < 2) {
#pragma unroll
                for (int ai = 0; ai < 2; ++ai)
#pragma unroll
                    for (int m = 0; m < 4; ++m) { float* rp = DT + (size_t)(row0 + ai * 128 + m * 16) * 64 + wc * 32 + 8 * fq;
                        *(GAS f32x4*)rp = acc[ai][0][m][0]; *(GAS f32x4*)(rp + 4) = acc[ai][0][m][1]; }
            }
            return;
        }
        const int col0 = colt + wc * 32 + 8 * fq; const unsigned patch = patch0 + (wr * 4 + wc) * EPI_PATCH_BYTES;
#define INPROJ_WALK(...) \
        _Pragma("unroll") for (int ai = 0; ai < 2; ++ai) _Pragma("unroll") for (int m = 0; m < 4; ++m) { bf16_t* rowu = O + (size_t)(u.pm * 256 + wr * 64 + ai * 128 + m * 16) * ldc + colt + wc * 32; \
            _Pragma("unroll") for (int bj = 0; bj < 2; ++bj) { f32x4 v0 = acc[ai][bj][m][0], v1 = acc[ai][bj][m][1]; __VA_ARGS__ \
                u32x4 w; w.x = cvt_pk_bf16(v0[0], v0[1]); w.y = cvt_pk_bf16(v0[2], v0[3]); w.z = cvt_pk_bf16(v1[0], v1[1]); w.w = cvt_pk_bf16(v1[2], v1[3]); \
                wave_store_rows(patch, ln_, w, (unsigned char*)(rowu + bj * 128), (size_t)ldc * 2); } asm volatile("" ::: "memory"); }
        if (mode == 0) { INPROJ_WALK() }
        else if (mode == 1) { INPROJ_WALK(_Pragma("unroll") for (int e = 0; e < 4; ++e) { v0[e] = silu_f(v0[e]); v1[e] = silu_f(v1[e]); }) }
        else { f32x4 bm[2][2];
            _Pragma("unroll") for (int bj = 0; bj < 2; ++bj) { bm[bj][0] = *(const GAS f32x4*)(b_merge + col0 + bj * 128); bm[bj][1] = *(const GAS f32x4*)(b_merge + col0 + bj * 128 + 4); }
            INPROJ_WALK({ _Pragma("unroll") for (int e = 0; e < 4; ++e) { v0[e] = sigm_f(v0[e] + bm[bj][0][e]); v1[e] = sigm_f(v1[e] + bm[bj][1][e]); } }) }
#undef INPROJ_WALK
    }
};
#define EPI_WALK(...) \
    const int row0_ = u.pm * 256 + wr * 64 + fr, col0_ = u.pn * 256 + wc * 32 + 8 * fq; \
    _Pragma("unroll") for (int ai = 0; ai < 2; ++ai) _Pragma("unroll") for (int m = 0; m < 4; ++m) { const size_t row = (size_t)(row0_ + ai * 128 + m * 16); \
    _Pragma("unroll") for (int bj = 0; bj < 2; ++bj) { const int col = col0_ + bj * 128; const f32x4 v0 = acc[ai][bj][m][0], v1 = acc[ai][bj][m][1]; __VA_ARGS__ } asm volatile("" ::: "memory"); }

#define EPI_ROW(g_) ((size_t)(row0_ + ((g_) >> 2) * 128 + ((g_) & 3) * 16))
#define EPI_ROWU(g_) ((size_t)(u.pm * 256 + wr * 64 + ((g_) >> 2) * 128 + ((g_) & 3) * 16))
struct EpiPool {
    static constexpr bool PERM = true, AFTER_DRAIN = false;
    bf16_t* YP; const bf16_t* SZP; const float* pscale; unsigned patch0;
    __device__ __forceinline__ void operator()(const f32x4 (&acc)[2][2][4][2], const pg8::Unit& u, int wr, int wc, int, int) const { const int ln_ = fresh_lane(), fr = ln_ & 15, fq = ln_ >> 4;
        const int row0_ = u.pm * 256 + wr * 64 + fr, col0_ = u.pn * 256 + wc * 32 + 8 * fq;
        f32x4 ps[2][2];
#pragma unroll
        for (int bj = 0; bj < 2; ++bj) { ps[bj][0] = *(const GAS f32x4*)(pscale + col0_ + bj * 128); ps[bj][1] = *(const GAS f32x4*)(pscale + col0_ + bj * 128 + 4); }
        u32x4 cur[2], nxt[2];
#pragma unroll
        for (int bj = 0; bj < 2; ++bj) { cur[bj] = *(const GAS u32x4*)(SZP + EPI_ROW(0) * 1024 + col0_ + bj * 128); nxt[bj] = cur[bj]; }
#pragma unroll
        for (int g = 0; g < 8; ++g) { const int ai = g >> 2, m = g & 3;
            if (g < 7) {
#pragma unroll
                for (int bj = 0; bj < 2; ++bj) nxt[bj] = *(const GAS u32x4*)(SZP + EPI_ROW(g + 1) * 1024 + col0_ + bj * 128); }
            asm volatile("" ::: "memory");
#pragma unroll
            for (int bj = 0; bj < 2; ++bj) { const f32x4 v0 = acc[ai][bj][m][0], v1 = acc[ai][bj][m][1]; float z[8]; unpack8(cur[bj], z); float o[8];
#pragma unroll
                for (int e = 0; e < 4; ++e) { o[e] = v0[e] * ps[bj][0][e] * z[e]; o[4 + e] = v1[e] * ps[bj][1][e] * z[4 + e]; }
                wave_store_rows(patch0 + (wr * 4 + wc) * EPI_PATCH_BYTES, ln_, pack8(o), (unsigned char*)(YP + EPI_ROWU(g) * 1024 + u.pn * 256 + wc * 32 + bj * 128), 2048); }
#pragma unroll
            for (int bj = 0; bj < 2; ++bj) cur[bj] = nxt[bj]; }
    }
};
struct EpiM1 {
    static constexpr bool PERM = true, AFTER_DRAIN = false;
    bf16_t* TMP; const bf16_t* GATES; unsigned patch0;
    __device__ __forceinline__ void operator()(const f32x4 (&acc)[2][2][4][2], const pg8::Unit& u, int wr, int wc, int, int) const { const int ln_ = fresh_lane(), fr = ln_ & 15, fq = ln_ >> 4;
        const int row0_ = u.pm * 256 + wr * 64 + fr, col0_ = u.pn * 256 + wc * 32 + 8 * fq;
        u32x4 cur[2], nxt[2];
#pragma unroll
        for (int bj = 0; bj < 2; ++bj) { cur[bj] = *(const GAS u32x4*)(GATES + EPI_ROW(0) * 2048 + col0_ + bj * 128); nxt[bj] = cur[bj]; }
#pragma unroll
        for (int g = 0; g < 8; ++g) { const int ai = g >> 2, m = g & 3;
            if (g < 7) {
#pragma unroll
                for (int bj = 0; bj < 2; ++bj) nxt[bj] = *(const GAS u32x4*)(GATES + EPI_ROW(g + 1) * 2048 + col0_ + bj * 128); }
            asm volatile("" ::: "memory");
#pragma unroll
            for (int bj = 0; bj < 2; ++bj) { const f32x4 v0 = acc[ai][bj][m][0], v1 = acc[ai][bj][m][1]; float gt[8]; unpack8(cur[bj], gt); float o[8];
#pragma unroll
                for (int e = 0; e < 4; ++e) { o[e] = v0[e] * gt[e]; o[4 + e] = v1[e] * gt[4 + e]; }
                wave_store_rows(patch0 + (wr * 4 + wc) * EPI_PATCH_BYTES, ln_, pack8(o), (unsigned char*)(TMP + EPI_ROWU(g) * 1024 + u.pn * 256 + wc * 32 + bj * 128), 2048); }
#pragma unroll
            for (int bj = 0; bj < 2; ++bj) cur[bj] = nxt[bj]; }
    }
};
struct EpiM2 {
    static constexpr bool PERM = true, AFTER_DRAIN = false;
    const bf16_t* TMP; const bf16_t* GATES; bf16_t* MRG; unsigned patch0;
    __device__ __forceinline__ void operator()(const f32x4 (&acc)[2][2][4][2], const pg8::Unit& u, int wr, int wc, int, int) const { const int ln_ = fresh_lane(), fr = ln_ & 15, fq = ln_ >> 4;
        const int row0_ = u.pm * 256 + wr * 64 + fr, col0_ = u.pn * 256 + wc * 32 + 8 * fq;
        u32x4 cg_[2], ng_[2], ct_[2], nt_[2];
#pragma unroll
        for (int bj = 0; bj < 2; ++bj) { cg_[bj] = *(const GAS u32x4*)(GATES + EPI_ROW(0) * 2048 + 1024 + col0_ + bj * 128); ct_[bj] = *(const GAS u32x4*)(TMP + EPI_ROW(0) * 1024 + col0_ + bj * 128); ng_[bj] = cg_[bj]; nt_[bj] = ct_[bj]; }
#pragma unroll
        for (int g = 0; g < 8; ++g) { const int ai = g >> 2, m = g & 3;
            if (g < 7) {
#pragma unroll
                for (int bj = 0; bj < 2; ++bj) { ng_[bj] = *(const GAS u32x4*)(GATES + EPI_ROW(g + 1) * 2048 + 1024 + col0_ + bj * 128); nt_[bj] = *(const GAS u32x4*)(TMP + EPI_ROW(g + 1) * 1024 + col0_ + bj * 128); } }
            asm volatile("" ::: "memory");
#pragma unroll
            for (int bj = 0; bj < 2; ++bj) { const f32x4 v0 = acc[ai][bj][m][0], v1 = acc[ai][bj][m][1]; float gt[8], tp[8]; unpack8(cg_[bj], gt); unpack8(ct_[bj], tp); float o[8];
#pragma unroll
                for (int e = 0; e < 4; ++e) { o[e] = tp[e] + v0[e] * gt[e]; o[4 + e] = tp[4 + e] + v1[e] * gt[4 + e]; }
                wave_store_rows(patch0 + (wr * 4 + wc) * EPI_PATCH_BYTES, ln_, pack8(o), (unsigned char*)(MRG + EPI_ROWU(g) * 1024 + u.pn * 256 + wc * 32 + bj * 128), 2048); }
#pragma unroll
            for (int bj = 0; bj < 2; ++bj) { cg_[bj] = ng_[bj]; ct_[bj] = nt_[bj]; } }
    }
};
struct EpiF32 {
    static constexpr bool PERM = true, AFTER_DRAIN = false;
    float* O;
    __device__ __forceinline__ void operator()(const f32x4 (&acc)[2][2][4][2], const pg8::Unit& u, int wr, int wc, int, int) const { const int ln_ = fresh_lane(), fr = ln_ & 15, fq = ln_ >> 4;
        EPI_WALK({ *(GAS f32x4*)(O + row * 1024 + col) = v0; *(GAS f32x4*)(O + row * 1024 + col + 4) = v1; })
    }
};
DI void transpose_item(const float* W, int K, int N, bf16_t* WT, int ldo, int row_off, LAS float* scr, int item, int lane) {
    const int nblk = N / 32, kb = item / nblk, nb = item % nblk, k0 = 64 * kb, n0 = 32 * nb;
#pragma unroll 8
    for (int i = 0; i < 32; ++i) { const int kk = 2 * i + (lane >> 5); scr[kk * 33 + (lane & 31)] = ((const GAS float*)W)[(size_t)(k0 + kk) * N + n0 + (lane & 31)]; }
    asm volatile("s_waitcnt lgkmcnt(0)" ::: "memory");
    const int c = lane & 7;
#pragma unroll
    for (int j = 0; j < 4; ++j) { const int n = (lane >> 3) + 8 * j; const LAS float* s = scr + (8 * c) * 33 + n;
        u32x4 o; o.x = cvt_pk_bf16(s[0 * 33], s[1 * 33]); o.y = cvt_pk_bf16(s[2 * 33], s[3 * 33]); o.z = cvt_pk_bf16(s[4 * 33], s[5 * 33]); o.w = cvt_pk_bf16(s[6 * 33], s[7 * 33]);
        *(GAS u32x4*)(WT + (size_t)(row_off + n0 + n) * ldo + k0 + 8 * c) = o; }
    asm volatile("s_waitcnt lgkmcnt(0)" ::: "memory");
}
DI void mod_item(LAS unsigned char* lds, const float* c, const float* c_ctx, const float* w_ada, const float* b_ada, float* MOD, int item, int tid) {
    LAS float* sS = (LAS float*)lds;
    LAS float* sP = (LAS float*)(lds + 17 * 1024 * 4);
    for (int i = tid; i < 17 * 1024; i += NTHR) { const float v = i < 16 * 1024 ? ((const GAS float*)c)[i] : ((const GAS float*)c_ctx)[i - 16 * 1024]; sS[i] = silu_f(v); }
    __syncthreads();
    const int col = tid & 63, kseg = tid >> 6, n = item * 64 + col;
    float acc[17];
#pragma unroll
    for (int r = 0; r < 17; ++r) acc[r] = 0.f;
    for (int k = kseg * 128; k < kseg * 128 + 128; ++k) { const float w = ((const GAS float*)w_ada)[(size_t)k * 3072 + n];
#pragma unroll
        for (int r = 0; r < 17; ++r) acc[r] += sS[r * 1024 + k] * w; }
#pragma unroll
    for (int r = 0; r < 17; ++r) sP[(kseg * 17 + r) * 64 + col] = acc[r];
    __syncthreads();
    for (int i = tid; i < 17 * 64; i += NTHR) { const int r = i >> 6, cc = i & 63; float s = ((const GAS float*)b_ada)[item * 64 + cc];
#pragma unroll
        for (int q = 0; q < 8; ++q) s += sP[(q * 17 + r) * 64 + cc];
        ((GAS float*)MOD)[r * 3072 + item * 64 + cc] = s; }
    __syncthreads();
}
DI void modnorm_row(const float* xrow, const float* npre, const float* mod, bf16_t* orow, int lane) {
    f32x4 v[4]; float ss = 0.f;
#pragma unroll
    for (int j = 0; j < 4; ++j) { v[j] = *(const GAS f32x4*)(xrow + 4 * lane + 256 * j); ss += (v[j].x * v[j].x + v[j].y * v[j].y) + (v[j].z * v[j].z + v[j].w * v[j].w); }
    const float rstd = rsqrtf(wave_sum(ss, lane) * (1.f / 1024.f) + EPS);
#pragma unroll
    for (int j = 0; j < 4; ++j) { const int c0 = 4 * lane + 256 * j; const f32x4 w = *(const GAS f32x4*)(npre + c0), sh = *(const GAS f32x4*)(mod + c0), sc = *(const GAS f32x4*)(mod + 1024 + c0);
        f32x4 o;
#pragma unroll
        for (int e = 0; e < 4; ++e) o[e] = v[j][e] * rstd * w[e] * (1.f + sc[e]) + sh[e];
        u32x2 p; p.x = cvt_pk_bf16(o[0], o[1]); p.y = cvt_pk_bf16(o[2], o[3]); *(GAS u32x2*)(orow + c0) = p; }
}
DI void final_row(float* yrow, const float* xrow, const float* npost, const float* gate, int lane) {
    f32x4 v[4]; float ss = 0.f;
#pragma unroll
    for (int j = 0; j < 4; ++j) { v[j] = *(const GAS f32x4*)(yrow + 4 * lane + 256 * j); ss += (v[j].x * v[j].x + v[j].y * v[j].y) + (v[j].z * v[j].z + v[j].w * v[j].w); }
    const float rstd = rsqrtf(wave_sum(ss, lane) * (1.f / 1024.f) + EPS);
#pragma unroll
    for (int j = 0; j < 4; ++j) { const int c0 = 4 * lane + 256 * j; const f32x4 w = *(const GAS f32x4*)(npost + c0), g = *(const GAS f32x4*)(gate + c0), x = *(const GAS f32x4*)(xrow + c0);
        f32x4 o;
#pragma unroll
        for (int e = 0; e < 4; ++e) o[e] = x[e] + g[e] * (v[j][e] * rstd * w[e]);
        *(GAS f32x4*)(yrow + c0) = o; }
}
DI void gnorm_item(bf16_t* yf, const bf16_t* yb, const bf16_t* szs, const float* w, int lane) {
    float a[8], b[8], z[8], u[8]; unpack8(*(const GAS u32x4*)(yf + lane * 8), a); unpack8(*(const GAS u32x4*)(yb + lane * 8), b); unpack8(*(const GAS u32x4*)(szs + lane * 8), z);
    float ss = 0.f;
#pragma unroll
    for (int e = 0; e < 8; ++e) { u[e] = (a[e] + b[e]) * z[e]; ss += u[e] * u[e]; }
    const float r = rsqrtf(wave_sum(ss, lane) * (1.f / 512.f) + EPS);
    const f32x4 w0 = *(const GAS f32x4*)(w + lane * 8), w1 = *(const GAS f32x4*)(w + lane * 8 + 4);
    float o[8];
#pragma unroll
    for (int e = 0; e < 4; ++e) { o[e] = u[e] * r * w0[e]; o[4 + e] = u[4 + e] * r * w1[e]; }
    *(GAS u32x4*)(yf + lane * 8) = pack8(o);
}

constexpr int RS = 272;
DI void conv_xs_wave(LAS unsigned char* wl, const bf16_t* src, int L, int c, int hb, bf16_t* dst_tile, const float* conv_w, const float* conv_b, int lane) {
    const int cp = lane & 31, th = lane >> 5, ch = hb * 64 + 2 * cp;
    float nk = -1.4426950408889634f; asm volatile("" : "+v"(nk));
    float w0[4], w1[4];
#pragma unroll
    for (int k = 0; k < 4; ++k) { w0[k] = ((const GAS float*)conv_w)[k * 3072 + ch]; w1[k] = ((const GAS float*)conv_w)[k * 3072 + ch + 1]; }
    const float b0 = ((const GAS float*)conv_b)[ch], b1 = ((const GAS float*)conv_b)[ch + 1];
    const int t0 = c * 128 + th * 64 - 2;
    unsigned raw[67];
#pragma unroll
    for (int r = 0; r < 67; ++r) { const int t = t0 + r; raw[r] = 0u; if (t >= 0 && t < L) raw[r] = *(const GAS unsigned*)(src + (size_t)t * 3072 + ch); }
#pragma unroll
    for (int blk = 0; blk < 8; ++blk) { float o0[8], o1[8];
#pragma unroll
        for (int u = 0; u < 8; ++u) { float s0 = b0, s1 = b1;
#pragma unroll
            for (int k = 0; k < 4; ++k) { s0 += w0[k] * bflo(raw[blk * 8 + u + k]); s1 += w1[k] * bfhi(raw[blk * 8 + u + k]); }
            o0[u] = silu_k(s0, nk); o1[u] = silu_k(s1, nk); }
        *(LAS u32x4*)(wl + (2 * cp) * RS + (th * 64 + blk * 8) * 2) = pack8(o0);
        *(LAS u32x4*)(wl + (2 * cp + 1) * RS + (th * 64 + blk * 8) * 2) = pack8(o1); }
    asm volatile("s_waitcnt lgkmcnt(0)" ::: "memory");
#pragma unroll
    for (int q = 0; q < 16; ++q) { const int row = q * 4 + (lane >> 4), cb = (lane & 15) * 16;
        *(GAS u32x4*)((char*)dst_tile + row * 256 + cb) = *(const LAS u32x4*)(wl + row * RS + cb); }
    asm volatile("s_waitcnt lgkmcnt(0)" ::: "memory");
}
DI void conv_bc_item(LAS unsigned char* lds, const bf16_t* src, int L, int c, int g, bf16_t* bt_tile, bf16_t* cg_rows, bf16_t* gt_tile, const float* conv_w, const float* conv_b, int tid) {
    LAS unsigned char* sB = lds; LAS unsigned char* sC = lds + 128 * RS;
    {
        float nk = -1.4426950408889634f; asm volatile("" : "+v"(nk));
        const int p_ = tid & 127, tq = tid >> 7, mat = p_ >> 6, n2 = 2 * (p_ & 63), ch = 2048 + mat * 512 + g * 128 + n2;
        LAS unsigned char* sM = mat ? sC : sB;
        float w0[4], w1[4];
#pragma unroll
        for (int k = 0; k < 4; ++k) { w0[k] = ((const GAS float*)conv_w)[k * 3072 + ch]; w1[k] = ((const GAS float*)conv_w)[k * 3072 + ch + 1]; }
        const float b0 = ((const GAS float*)conv_b)[ch], b1 = ((const GAS float*)conv_b)[ch + 1];
        unsigned raw[4][11];
#pragma unroll
        for (int ps = 0; ps < 4; ++ps)
#pragma unroll
            for (int r = 0; r < 11; ++r) { const int t = c * 128 + (ps * 4 + tq) * 8 - 2 + r; raw[ps][r] = 0u; if (t >= 0 && t < L) raw[ps][r] = *(const GAS unsigned*)(src + (size_t)t * 3072 + ch); }
#pragma unroll
        for (int ps = 0; ps < 4; ++ps) { const int tk0 = (ps * 4 + tq) * 8; float o0[8], o1[8];
#pragma unroll
            for (int u = 0; u < 8; ++u) { float s0 = b0, s1 = b1;
#pragma unroll
                for (int k = 0; k < 4; ++k) { s0 += w0[k] * bflo(raw[ps][u + k]); s1 += w1[k] * bfhi(raw[ps][u + k]); }
                o0[u] = silu_k(s0, nk); o1[u] = silu_k(s1, nk);
                *(LAS unsigned*)(sM + (tk0 + u) * RS + n2 * 2) = cvt_pk_bf16(o0[u], o1[u]); }
            if (mat == 0) { const int cb_ = ((tk0 >> 5) * 64 + ((tk0 >> 3) & 3) * 16) * 16;
                *(GAS u32x4*)((char*)bt_tile + ((n2 >> 4) * 4096 + cb_ + (n2 & 15) * 16)) = pack8(o0); *(GAS u32x4*)((char*)bt_tile + (((n2 + 1) >> 4) * 4096 + cb_ + ((n2 + 1) & 15) * 16)) = pack8(o1); } }
    }
    __syncthreads();
    if (cg_rows) {
#pragma unroll
        for (int q = 0; q < 4; ++q) { const int f = tid + 512 * q, rb = f >> 8, ks = (f >> 6) & 3, ln = f & 63;
            *(GAS u32x4*)((char*)cg_rows + f * 16) = *(const LAS u32x4*)(sC + (rb * 16 + (ln & 15)) * RS + (ks * 32 + (ln >> 4) * 8) * 2); } }
    if (gt_tile) { const int wid = tid >> 6, lane = tid & 63, fr = lane & 15, fq = lane >> 4;
        f32x4 acc[8];
#pragma unroll
        for (int jb = 0; jb < 8; ++jb) acc[jb] = (f32x4){0.f, 0.f, 0.f, 0.f};
#pragma unroll
        for (int ks = 0; ks < 4; ++ks) { const bf16x8 cf = *(const LAS bf16x8*)(sC + (16 * wid + fr) * RS + (ks * 32 + fq * 8) * 2);
#pragma unroll
            for (int jb = 0; jb < 8; ++jb) { const bf16x8 bfr = *(const LAS bf16x8*)(sB + (jb * 16 + fr) * RS + (ks * 32 + fq * 8) * 2); acc[jb] = MFMA16(bfr, cf, acc[jb]); } }
#pragma unroll
        for (int jb = 0; jb < 8; ++jb) { u32x2 p; p.x = cvt_pk_bf16(acc[jb][0], acc[jb][1]); p.y = cvt_pk_bf16(acc[jb][2], acc[jb][3]);
            *(GAS u32x2*)((char*)gt_tile + ((wid * 4 + (jb >> 1)) * 1024 + (((jb & 1) * 2 + (fq >> 1)) * 16 + fr) * 16 + (fq & 1) * 8)) = p; } }
    __syncthreads();
}
constexpr float LOG2E = 1.4426950408889634f;
DI void dt_item(LAS unsigned char* lds, const float* dtr, int L, int c, float* dtv, float* acs, size_t dir_stride, const float* dt_bias, const float* a_log, int tid) {
    LAS float* sTot = (LAS float*)lds;
    const int col = tid & 63, seg = tid >> 6, dir = col >> 5, h = col & 31;
    const float bias = ((const GAS float*)dt_bias)[col], A = -__expf(((const GAS float*)a_log)[col]);
    float dtl[16], cs[16];
#pragma unroll
    for (int u = 0; u < 16; ++u) { const float x = ((const GAS float*)dtr)[(size_t)(c * 128 + seg * 16 + u) * 64 + col] + bias; const float e = __builtin_amdgcn_exp2f(x * 1.4426950408889634f);
        const float sp = e < 0.03125f ? e * (1.f - e * (0.5f - e * (0.33333334f - 0.25f * e))) : 0.6931471805599453f * __builtin_amdgcn_logf(1.f + e);
        dtl[u] = x > 20.f ? x : sp; }
    float run = 0.f;
    if (dir == 0) {
#pragma unroll
        for (int u = 0; u < 16; ++u) { run += dtl[u] * A; cs[u] = run; }
    } else {
#pragma unroll
        for (int u = 15; u >= 0; --u) { run += dtl[u] * A; cs[u] = run; }
    }
    sTot[seg * 64 + col] = run;
    __syncthreads();
    float off = 0.f;
#pragma unroll
    for (int s = 0; s < 8; ++s) { const float v = sTot[s * 64 + col]; if (dir == 0 ? (s < seg) : (s > seg)) off += v; }
    const size_t o = (size_t)dir * dir_stride + (size_t)h * L + c * 128 + seg * 16;
#pragma unroll
    for (int q = 0; q < 4; ++q) { *(GAS f32x4*)(dtv + o + 4 * q) = (f32x4){dtl[4 * q], dtl[4 * q + 1], dtl[4 * q + 2], dtl[4 * q + 3]};
        *(GAS f32x4*)(acs + o + 4 * q) = (f32x4){(cs[4 * q] + off) * LOG2E, (cs[4 * q + 1] + off) * LOG2E, (cs[4 * q + 2] + off) * LOG2E, (cs[4 * q + 3] + off) * LOG2E}; }
    __syncthreads();
}
DI void pool_wave(LAS unsigned char* wl, const bf16_t* v, bf16_t* dd, int r, int gi, int cq, int lane) {
    LAS float* sV = (LAS float*)wl;
    const int k = 2 << gi, lo = k >> 1, hi = k - 1 - lo;
    const int c8 = lane & 7, wq = lane >> 3, ch = gi * 256 + cq * 64 + c8 * 8;
    const int r_lo = max(r - lo, 0), r_hi = min(r + hi + 1, 64);
    const float inv_r = 1.f / (float)(r_hi - r_lo);
    float acc[8][8]; u32x4 ctr[8];
#pragma unroll
    for (int q = 0; q < 8; ++q) { ctr[q] = (u32x4){0u, 0u, 0u, 0u};
#pragma unroll
        for (int e = 0; e < 8; ++e) acc[q][e] = 0.f; }
    for (int rr = r_lo; rr < r_hi; ++rr) { u32x4 x[8];
#pragma unroll
        for (int q = 0; q < 8; ++q) x[q] = *(const GAS u32x4*)(v + ((size_t)(rr * 64 + wq * 8 + q) * 1024 + ch));
#pragma unroll
        for (int q = 0; q < 8; ++q) { float f[8]; unpack8(x[q], f);
#pragma unroll
            for (int e = 0; e < 8; ++e) acc[q][e] += f[e];
            if (rr == r) ctr[q] = x[q]; } }
#pragma unroll
    for (int q = 0; q < 8; ++q) { LAS float* p = sV + (wq * 8 + q) * 68 + c8 * 8;
        *(LAS f32x4*)p = (f32x4){acc[q][0] * inv_r, acc[q][1] * inv_r, acc[q][2] * inv_r, acc[q][3] * inv_r};
        *(LAS f32x4*)(p + 4) = (f32x4){acc[q][4] * inv_r, acc[q][5] * inv_r, acc[q][6] * inv_r, acc[q][7] * inv_r}; }
    asm volatile("s_waitcnt lgkmcnt(0)" ::: "memory");
    const int wb = wq * 8;
    f32x4 s0 = (f32x4){0.f, 0.f, 0.f, 0.f}, s1 = s0;
    for (int ww = max(wb - lo, 0); ww < min(wb + hi + 1, 64); ++ww) { const LAS float* p = sV + ww * 68 + c8 * 8; s0 += *(const LAS f32x4*)p; s1 += *(const LAS f32x4*)(p + 4); }
#pragma unroll
    for (int q = 0; q < 8; ++q) { const int w = wb + q, w_lo = max(w - lo, 0), w_hi = min(w + hi + 1, 64);
        const float inv_w = 1.f / (float)(w_hi - w_lo); float cv[8]; unpack8(ctr[q], cv); float o[8];
#pragma unroll
        for (int e = 0; e < 4; ++e) { o[e] = s0[e] * inv_w - cv[e]; o[4 + e] = s1[e] * inv_w - cv[4 + e]; }
        *(GAS u32x4*)(dd + ((size_t)(r * 64 + w) * 1024 + ch)) = pack8(o);
        if (q < 7) { const int wa = w + 1 + hi, ws_ = w - lo;
            if (wa < 64) { const LAS float* p = sV + wa * 68 + c8 * 8; s0 += *(const LAS f32x4*)p; s1 += *(const LAS f32x4*)(p + 4); }
            if (ws_ >= 0) { const LAS float* p = sV + ws_ * 68 + c8 * 8; s0 -= *(const LAS f32x4*)p; s1 -= *(const LAS f32x4*)(p + 4); } } }
    asm volatile("s_waitcnt lgkmcnt(0)" ::: "memory");
}
#define LDS_BARRIER() do { asm volatile("s_waitcnt lgkmcnt(0)" ::: "memory"); __builtin_amdgcn_s_barrier(); asm volatile("" ::: "memory"); } while (0)
DI void ssd_phase(LAS unsigned char* lds, const unsigned char* ws, const float* d_skip_p, int b0, int vcu, int G, int tid_in) {
    int tid_l = tid_in; asm volatile("" : "+v"(tid_l));
    const int tid = tid_l, wid = __builtin_amdgcn_readfirstlane(tid >> 6), lane = tid & 63, fr = lane & 15, fq = lane >> 4;
    constexpr int TILE = 64 * RS, OFF_HB = 2 * TILE, OFF_SC = 4 * TILE, OFF_Y = OFF_SC + 4096;
    const unsigned lb = (unsigned)(size_t)lds;
    unsigned a_frag = lb + fr * RS + fq * 16, a_f = lb + OFF_SC + fq * 32, a_xw = lb + (tid >> 3) * RS + (tid & 7) * 32, a_hw = lb + OFF_HB + fr * RS + wid * 32 + fq * 8,
             a_ai = lb + OFF_SC + 512 + (wid * 16 + fr) * 4, a_sc = lb + OFF_SC;
    asm volatile("" : "+v"(a_frag), "+v"(a_f), "+v"(a_xw), "+v"(a_hw), "+v"(a_ai), "+v"(a_sc));
    unsigned ln_bt = wid * 4096 + lane * 16, ln_xt = tid * 32;
    asm volatile("" : "+v"(ln_bt), "+v"(ln_xt));
#define LN_DA() ({ unsigned t_ = ln_xt; asm volatile("" : "+v"(t_)); t_ >> 3; })
#define XTF(q, pb, ks) (*(const LAS bf16x8*)(a_frag + ((q) * TILE + (pb) * 16 * RS + (ks) * 64)))
#define HBF(q, pb, ks) (*(const LAS bf16x8*)(a_frag + (OFF_HB + (q) * TILE + (pb) * 16 * RS + (ks) * 64)))
#define SCV(q, arr, ks, half) (*(const LAS f32x4*)(a_f + ((q) * 2048 + (arr) * 512 + (ks) * 128 + (half) * 16)))
    for (int pair = vcu; pair < NB * 32; pair += G) {
        const int hh = pair & 7, g = (pair >> 3) & 3, bl = pair >> 5, h = g * 8 + hh, bg = b0 + bl;
        const float dsk = ((const GAS float*)d_skip_p)[h];
        f32x4 accH[2][4];
        u32x4 xt0[2], xt1[2]; bf16x8 bt[2][4], gt[2][4], cgf[2][4]; float r_dt[2], r_acs[2], r_alast[2], r_ref[2];
#pragma unroll
        for (int q = 0; q < 2; ++q) { xt0[q] = (u32x4){0u, 0u, 0u, 0u}; xt1[q] = xt0[q]; r_dt[q] = 0.f; r_acs[q] = 0.f; r_alast[q] = 0.f; r_ref[q] = 0.f;
#pragma unroll
            for (int k = 0; k < 4; ++k) { accH[q][k] = (f32x4){0.f, 0.f, 0.f, 0.f}; bt[q][k] = (bf16x8){0, 0, 0, 0, 0, 0, 0, 0}; gt[q][k] = bt[q][k]; cgf[q][k] = bt[q][k]; } }
#define UNI(v_) asm volatile("" : "+s"(v_))
#define SSD_LOAD_XT_DA(q, s_) do { const int s__ = (s_); unsigned xo, dof, aof; \
        if (s__ < 2) { const int cc = q == 0 ? s__ : 1 - s__; xo = (unsigned)WS_CXT + (unsigned)((bg * 2 + cc) * 2048 + h * 64) * 256u; const unsigned o = ((unsigned)((q * 16 + bg) * 32 + h) * 256u + cc * 128) * 4u; dof = (unsigned)WS_CDTV + o; aof = (unsigned)WS_CACS + o; } \
        else { const int c_ = q == 0 ? s__ - 2 : 33 - s__; xo = (unsigned)WS_XT + (unsigned)((bl * 32 + c_) * 2048 + h * 64) * 256u; const unsigned o = ((unsigned)((q * NB + bl) * 32 + h) * 4096u + c_ * 128) * 4u; dof = (unsigned)WS_DTV + o; aof = (unsigned)WS_ACS + o; } \
        UNI(xo); UNI(dof); UNI(aof); const unsigned char* xp = ws + xo; const unsigned char* dp = ws + dof; const unsigned char* ap = ws + aof; \
        xt0[q] = *(const GAS u32x4*)(xp + ln_xt); xt1[q] = *(const GAS u32x4*)(xp + ln_xt + 16); \
        if (tid < 128) { const unsigned ln_da = LN_DA(); r_dt[q] = *(const GAS float*)(dp + ln_da); r_acs[q] = *(const GAS float*)(ap + ln_da); r_ref[q] = *(const GAS float*)(ap + (q == 0 ? (ln_da | 124u) : (ln_da & ~124u))); } r_alast[q] = *(const GAS float*)(ap + (q == 0 ? 127 * 4 : 0)); } while (0)
#define SSD_LOAD_BT(q, s_) do { const int s__ = (s_); unsigned bo; \
        if (s__ < 2) { const int cc = q == 0 ? s__ : 1 - s__; bo = (unsigned)WS_CBT + (unsigned)((bg * 2 + cc) * 512 + g * 128) * 256u; } \
        else { const int c_ = q == 0 ? s__ - 2 : 33 - s__; bo = (unsigned)WS_BT + (unsigned)((bl * 32 + c_) * 512 + g * 128) * 256u; } \
        UNI(bo); const unsigned char* bp = ws + bo; \
        _Pragma("unroll") for (int ks = 0; ks < 4; ++ks) bt[q][ks] = *(const GAS bf16x8*)(bp + ln_bt + ks * 1024); } while (0)
#define SSD_LOAD_GT_CG(q, s_) do { const int c_ = q == 0 ? (s_) - 2 : 33 - (s_); \
        unsigned go = (unsigned)WS_GT + (unsigned)(((bl * 32 + c_) * 4 + g) * 128) * 256u, co = (unsigned)WS_CG + (unsigned)(((bl * 32 + c_) * 4 + g) * 128) * 256u; \
        UNI(go); UNI(co); const unsigned char* gp = ws + go; const unsigned char* cp_ = ws + co; \
        _Pragma("unroll") for (int ks = 0; ks < 4; ++ks) { gt[q][ks] = *(const GAS bf16x8*)(gp + ln_bt + ks * 1024); cgf[q][ks] = *(const GAS bf16x8*)(cp_ + ln_bt + ks * 1024); } } while (0)
        SSD_LOAD_XT_DA(0, 0); SSD_LOAD_XT_DA(1, 0); SSD_LOAD_BT(0, 0); SSD_LOAD_BT(1, 0);
        for (int s = 0; s < 34; ++s) {
            float alast[2];
#pragma unroll
            for (int q = 0; q < 2; ++q) {
                *(LAS u32x4*)(a_xw + q * TILE) = xt0[q]; *(LAS u32x4*)(a_xw + (q * TILE + 16)) = xt1[q];
#pragma unroll
                for (int pb = 0; pb < 4; ++pb) { u32x2 pk; pk.x = cvt_pk_bf16(accH[q][pb][0], accH[q][pb][1]); pk.y = cvt_pk_bf16(accH[q][pb][2], accH[q][pb][3]);
                    *(LAS u32x2*)(a_hw + (q * TILE + pb * 16 * RS)) = pk; }
                alast[q] = r_alast[q];
                if (tid < 128) { const unsigned a_sw = a_sc + LN_DA(); *(LAS float*)(a_sw + q * 2048) = r_dt[q]; *(LAS float*)(a_sw + (q * 2048 + 512)) = r_acs[q]; *(LAS float*)(a_sw + (q * 2048 + 1024)) = r_dt[q] * __builtin_amdgcn_exp2f(alast[q] - r_acs[q]);
                    *(LAS float*)(a_sw + (q * 2048 + 1536)) = r_dt[q] * __builtin_amdgcn_exp2f(r_ref[q] - r_acs[q]); }
            }
            LDS_BARRIER();
            if (s + 1 < 34) { SSD_LOAD_XT_DA(0, s + 1); SSD_LOAD_XT_DA(1, s + 1); }
            if (s >= 2) {
#pragma unroll
              for (int q = 0; q < 2; ++q) {
                const int c_ = q == 0 ? s - 2 : 33 - s;
                f32x4 accD[4];
#pragma unroll
                for (int pb = 0; pb < 4; ++pb) accD[pb] = (f32x4){0.f, 0.f, 0.f, 0.f};
                int i_l = wid * 16 + fr; asm volatile("" : "+v"(i_l)); const int i = i_l;
                const float acs_i = *(const LAS float*)(a_ai + q * 2048);
                const float ei = __builtin_amdgcn_exp2f(acs_i);
#pragma unroll
                for (int ks = 0; ks < 4; ++ks)
#pragma unroll
                    for (int pb = 0; pb < 4; ++pb) { const bf16x8 a = HBF(q, pb, ks); accD[pb] = MFMA16(a, cgf[q][ks], accD[pb]); }
#pragma unroll
                for (int pb = 0; pb < 4; ++pb) accD[pb] *= ei;
                const int ksd = wid >> 1;
#pragma unroll
                for (int ks = 0; ks < 4; ++ks) {
                    if (q == 0 ? (ks < ksd) : (ks > ksd)) {
                        const float R = *(const LAS float*)(a_sc + (q * 2048 + 512 + (q == 0 ? 32 * ks + 31 : 32 * ks) * 4));
                        const float rowf = __builtin_amdgcn_exp2f(acs_i - R);
                        const f32x4 c0 = SCV(q, 3, ks, 0), c1 = SCV(q, 3, ks, 1);
                        float gv[8]; unpack8(__builtin_bit_cast(u32x4, gt[q][ks]), gv); float mv[8];
#pragma unroll
                        for (int e = 0; e < 4; ++e) { mv[e] = gv[e] * (c0[e] * rowf); mv[4 + e] = gv[4 + e] * (c1[e] * rowf); }
                        const bf16x8 mf = __builtin_bit_cast(bf16x8, pack8(mv));
#pragma unroll
                        for (int pb = 0; pb < 4; ++pb) { const bf16x8 a = XTF(q, pb, ks); accD[pb] = MFMA16(a, mf, accD[pb]); }
                    } else if (ks == ksd) {
                        const int j0 = ks * 32 + fq * 8;
                        const f32x4 a0 = SCV(q, 1, ks, 0), a1 = SCV(q, 1, ks, 1), d0 = SCV(q, 0, ks, 0), d1 = SCV(q, 0, ks, 1);
                        float gv[8]; unpack8(__builtin_bit_cast(u32x4, gt[q][ks]), gv); float mv[8];
#pragma unroll
                        for (int e = 0; e < 8; ++e) { const int j = j0 + e; const float aj = e < 4 ? a0[e & 3] : a1[e & 3], dj = e < 4 ? d0[e & 3] : d1[e & 3];
                            const bool valid = q == 0 ? (j <= i) : (j >= i);
                            float val = gv[e] * __builtin_amdgcn_exp2f(acs_i - aj) * dj; if (q == 0 && j == i) val += dsk;
                            mv[e] = valid ? val : 0.f; }
                        const bf16x8 mf = __builtin_bit_cast(bf16x8, pack8(mv));
#pragma unroll
                        for (int pb = 0; pb < 4; ++pb) { const bf16x8 a = XTF(q, pb, ks); accD[pb] = MFMA16(a, mf, accD[pb]); }
                    }
                }
                unsigned yo = (unsigned)(q == 0 ? WS_YF : WS_YB) + ((unsigned)(bl * 4096 + c_ * 128) * 2048u + h * 64) * 2u; UNI(yo);
                { unsigned t_ = ln_bt; asm volatile("" : "+v"(t_)); const unsigned ln = (t_ >> 4) & 63u, wv = t_ >> 12;
                  const unsigned yw = lb + OFF_Y + wv * 2304u + (ln & 15u) * 144u + (ln >> 4) * 8u, yr = lb + OFF_Y + wv * 2304u + (ln >> 3) * 144u + (ln & 7u) * 16u;
#pragma unroll
                  for (int pb = 0; pb < 4; ++pb) { u32x2 pk; pk.x = cvt_pk_bf16(accD[pb][0], accD[pb][1]); pk.y = cvt_pk_bf16(accD[pb][2], accD[pb][3]); *(LAS u32x2*)(yw + pb * 32) = pk; }
                  asm volatile("s_waitcnt lgkmcnt(0)" ::: "memory");
                  const u32x4 r0 = *(const LAS u32x4*)(yr), r1 = *(const LAS u32x4*)(yr + 8 * 144);
                  unsigned char* yrow = (unsigned char*)ws + yo + ((wv * 16u + (ln >> 3)) * 4096u + (ln & 7u) * 16u);
                  *(GAS u32x4*)(yrow) = r0; *(GAS u32x4*)(yrow + 8 * 4096) = r1;
                  asm volatile("s_waitcnt lgkmcnt(0)" ::: "memory"); }
                if (s + 1 < 34) SSD_LOAD_GT_CG(q, s + 1);
              }
            } else if (s + 1 >= 2) { SSD_LOAD_GT_CG(0, s + 1); SSD_LOAD_GT_CG(1, s + 1); }
#pragma unroll
            for (int q = 0; q < 2; ++q) {
                const float dec = __builtin_amdgcn_exp2f(alast[q]);
#pragma unroll
                for (int pb = 0; pb < 4; ++pb) accH[q][pb] *= dec;
#pragma unroll
                for (int ks = 0; ks < 4; ++ks) {
                    const f32x4 w0 = SCV(q, 2, ks, 0), w1 = SCV(q, 2, ks, 1);
                    float bv[8]; unpack8(__builtin_bit_cast(u32x4, bt[q][ks]), bv);
#pragma unroll
                    for (int e = 0; e < 4; ++e) { bv[e] *= w0[e]; bv[4 + e] *= w1[e]; }
                    const bf16x8 bw = __builtin_bit_cast(bf16x8, pack8(bv));
#pragma unroll
                    for (int pb = 0; pb < 4; ++pb) { const bf16x8 xf = XTF(q, pb, ks); accH[q][pb] = MFMA16(bw, xf, accH[q][pb]); } }
                if (s + 1 < 34) SSD_LOAD_BT(q, s + 1);
            }
            LDS_BARRIER();
        }
#undef SSD_LOAD_XT_DA
#undef SSD_LOAD_BT
#undef SSD_LOAD_GT_CG
#undef UNI
#undef LN_DA
#undef XTF
#undef HBF
#undef SCV
    }
}

#define RLX_AGENT __ATOMIC_RELAXED, __HIP_MEMORY_SCOPE_AGENT
#define XB_TMO      128
#define XB_XCNT(j)  (256  + 64 * (j))
#define XB_XSUB(j)  (1280 + 64 * (j))
#define XB_XGEN(j)  (2304 + 64 * (j))
#define XB_TOP      3328
#define XB_TOPGEN   3392
#define XCD_BAR_WORDS 3456
#define XB_SPIN_CAP (1u << 18)

__device__ __forceinline__ unsigned xb_ld(unsigned* p)              { return __hip_atomic_load(p, __ATOMIC_RELAXED, __HIP_MEMORY_SCOPE_AGENT); }
__device__ __forceinline__ unsigned xb_add(unsigned* p, unsigned v) { return __hip_atomic_fetch_add(p, v, __ATOMIC_RELAXED, __HIP_MEMORY_SCOPE_AGENT); }
__device__ __forceinline__ unsigned xb_xcc_id() { return (unsigned)__builtin_amdgcn_s_getreg((3 << 11) | 20) & 0xFu; }
#define XB_SPIN(cond, bar) do { unsigned _sp = 0; while (cond) { __builtin_amdgcn_s_sleep(1); \
    if ((++_sp & 255u) == 0u) { if (xb_ld(&(bar)[XB_TMO])) break; if (_sp > XB_SPIN_CAP) { atomicAdd(&(bar)[XB_TMO], 1u); break; } } } } while (0)

struct XcdBarrier {
    unsigned* bar; unsigned x;
    volatile LAS unsigned* st;
};

__device__ __forceinline__ XcdBarrier xcd_barrier_post(unsigned* bar, volatile LAS unsigned* st) {
    XcdBarrier b; b.bar = bar; b.x = xb_xcc_id(); b.st = st;
    if (threadIdx.x == 0) (void)xb_add(&bar[XB_XCNT(b.x)], 1u);
    return b;
}
__device__ __forceinline__ void xcd_barrier_complete(unsigned* bar, unsigned x, unsigned& nloc, unsigned& nx) {
    const unsigned G = gridDim.x * gridDim.y * gridDim.z;
    unsigned sum, cnt, mine, sp = 0u;
    for (;;) {
        sum = 0u; cnt = 0u; mine = 0u;
#pragma unroll
        for (unsigned j = 0; j < 16; ++j) { const unsigned c = xb_ld(&bar[XB_XCNT(j)]); sum += c; cnt += (c > 0u) ? 1u : 0u; mine = (j == x) ? c : mine; }
        if (sum == G) break;
        __builtin_amdgcn_s_sleep(1);
        if ((++sp & 255u) == 0u) { if (xb_ld(&bar[XB_TMO])) break; if (sp > XB_SPIN_CAP) { atomicAdd(&bar[XB_TMO], 1u); break; } }
    }
    nloc = mine > 0u ? mine : 1u; nx = cnt > 0u ? cnt : 1u;
}

__device__ __forceinline__ void xcd_barrier(const XcdBarrier& b, bool leader) {
    asm volatile("s_waitcnt vmcnt(0)" ::: "memory");
    __syncthreads();
    if (leader) {
        unsigned* bar = b.bar;
        __builtin_amdgcn_s_waitcnt(0);
        unsigned nloc = b.st[0], nx = b.st[1];
        if (nloc == 0u) { xcd_barrier_complete(bar, b.x, nloc, nx); b.st[0] = nloc; b.st[1] = nx; }
        const unsigned old = xb_add(&bar[XB_XSUB(b.x)], 1u);
        const unsigned gen = old / nloc;
        if (old + 1u == (gen + 1u) * nloc) {
            __builtin_amdgcn_fence(__ATOMIC_RELEASE, "agent");
            asm volatile("s_waitcnt vmcnt(0)" ::: "memory");
            const unsigned og = xb_add(&bar[XB_TOP], 1u);
            const unsigned tg = og / nx;
            if (og + 1u == (tg + 1u) * nx) xb_add(&bar[XB_TOPGEN], 1u);
            else XB_SPIN(xb_ld(&bar[XB_TOPGEN]) == tg, bar);
            __builtin_amdgcn_fence(__ATOMIC_ACQUIRE, "agent");
            xb_add(&bar[XB_XGEN(b.x)], 1u);
            asm volatile("s_waitcnt vmcnt(0)" ::: "memory");
        } else {
            XB_SPIN(xb_ld(&bar[XB_XGEN(b.x)]) == gen, bar);
            __builtin_amdgcn_fence(__ATOMIC_ACQUIRE, "agent");
            asm volatile("s_waitcnt vmcnt(0)" ::: "memory");
        }
    }
    __syncthreads();
}

struct Args { const float* in[21]; float* out; unsigned char* ws; int ph_lo, ph_hi; };
static_assert(sizeof(Args) == 23 * 8 + 8, "Args has no padding");


#if defined(__HIP_DEVICE_COMPILE__)
#define ASSUME_GLOBAL(p_) __builtin_assume(!__builtin_amdgcn_is_shared(p_) && !__builtin_amdgcn_is_private(p_))
#else
#define ASSUME_GLOBAL(p_) ((void)0)
#endif
#define IN_(k) (args.in[k])
#define x_in IN_(0)
#define c_in IN_(1)
#define ctx IN_(2)
#define c_ctx IN_(3)
#define w_ada IN_(4)
#define b_ada IN_(5)
#define norm_pre IN_(6)
#define norm_post IN_(7)
#define w_in IN_(8)
#define b_merge IN_(9)
#define pool_w IN_(10)
#define pool_scale IN_(11)
#define conv_w IN_(12)
#define conv_b IN_(13)
#define dt_bias IN_(14)
#define a_log IN_(15)
#define d_skip IN_(16)
#define ssd_norm IN_(17)
#define w_proj_pool IN_(18)
#define w_proj_ssd IN_(19)
#define w_out IN_(20)
#define out_p (args.out)
#define WSB(off) ((bf16_t*)(ws_l + (off)))
#define WSF(off) ((float*)(ws_l + (off)))
#define WIN WSB(WS_WIN)
#define WPP WSB(WS_WPP)
#define WPS WSB(WS_WPS)
#define WO WSB(WS_WO)
#define PW WSB(WS_PW)
#define MOD WSF(WS_MOD)
#define HC WSB(WS_HC)
#define CXBC WSB(WS_CXBC)
#define CXT WSB(WS_CXT)
#define CBT WSB(WS_CBT)
#define CDT WSF(WS_CDT)
#define CDTV WSF(WS_CDTV)
#define CACS WSF(WS_CACS)
#define HX WSB(WS_HX)
#define V WSB(WS_V)
#define SZS WSB(WS_SZS)
#define GATES WSB(WS_GATES)
#define XBC WSB(WS_XBC)
#define DTR WSF(WS_DTR)
#define DTV WSF(WS_DTV)
#define ACS WSF(WS_ACS)
#define XT WSB(WS_XT)
#define CG WSB(WS_CG)
#define BT WSB(WS_BT)
#define GT WSB(WS_GT)
#define YF WSB(WS_YF)
#define YP WSB(WS_YP)
#define YB WSB(WS_YB)
#define MRG WSB(WS_MRG)
__global__ void __launch_bounds__(NTHR, 2) fwd_megakernel(Args args) {
    extern __shared__ __attribute__((aligned(16))) unsigned char lds_raw[];
    cg::grid_group grid = cg::this_grid();
    LAS unsigned char* lds = (LAS unsigned char*)lds_raw;
#pragma unroll
    for (int k_ = 0; k_ < 21; ++k_) ASSUME_GLOBAL(args.in[k_]);
    ASSUME_GLOBAL(args.out);
    grid.sync();
    { volatile LAS unsigned* st0 = (volatile LAS unsigned*)(lds + LDS_BYTES - 64); if (threadIdx.x < 16) st0[threadIdx.x] = 0u; }
    __syncthreads();
    const XcdBarrier bar = xcd_barrier_post((unsigned*)(GAS unsigned*)(args.ws + WS_BAR), (volatile LAS unsigned*)(lds + LDS_BYTES - 64));
    const int G = gridDim.x, bx = blockIdx.x, NGW = G * 8, wave_k = __builtin_amdgcn_readfirstlane((int)threadIdx.x >> 6);
    const int lo = args.ph_lo, hi = args.ph_hi;
    int ph = 0;
#ifndef PROBE_MASK
#define PROBE_MASK 0
#endif
#define PHASE_BEGIN(id_) if (lo <= ph && ph < hi) { for (int rep_ = 0; rep_ <= ((PROBE_MASK >> (id_)) & 1); ++rep_) { if (rep_) __syncthreads(); int tid_l = wave_k * 64 + fresh_lane(); asm volatile("" : "+v"(tid_l)); const int tid = tid_l, lane = tid & 63, wave = wave_k; \
        int vcu_l = (G % 8 == 0) ? (bx % 8) * (G / 8) + bx / 8 : bx; asm volatile("" : "+s"(vcu_l)); const int vcu = vcu_l, gw = vcu * 8 + wave; (void)tid; (void)lane; (void)gw; \
        unsigned char* ws_l = args.ws; asm volatile("" : "+s"(ws_l)); ASSUME_GLOBAL(ws_l);
#define PHASE_END } } ++ph; if (lo < ph && ph < hi) xcd_barrier(bar, wave_k == 0 && fresh_lane() == 0);

    PHASE_BEGIN(0)
        for (int it = vcu; it < 48; it += G) mod_item(lds, c_in, c_ctx, w_ada, b_ada, MOD, it, tid);
        LAS float* scr = (LAS float*)(lds + wave * 16384);
        constexpr int I_IN = 16 * 290, I_PP = 16 * 32, I_PS = 32 * 32, I_O = 16 * 32, I_PW = 4 * 8;
        for (int it = gw; it < I_IN + I_PP + I_PS + I_O + 4 * I_PW; it += NGW) {
            int r = it;
            if (r < I_IN) { transpose_item(w_in, 1024, 9280, WIN, 1024, 0, scr, r, lane); continue; } r -= I_IN;
            if (r < I_PP) { transpose_item(w_proj_pool, 1024, 1024, WPP, 1024, 0, scr, r, lane); continue; } r -= I_PP;
            if (r < I_PS) { transpose_item(w_proj_ssd, 2048, 1024, WPS, 2048, 0, scr, r, lane); continue; } r -= I_PS;
            if (r < I_O) { transpose_item(w_out, 1024, 1024, WO, 1024, 0, scr, r, lane); continue; } r -= I_O;
            { const int gq = r / I_PW; transpose_item(pool_w + (size_t)gq * 65536, 256, 256, PW, 256, gq * 256, scr, r % I_PW, lane); }
        }
    PHASE_END
    PHASE_BEGIN(1)
        for (int m = gw; m < CT; m += NGW) modnorm_row(ctx + (size_t)m * 1024, norm_pre, MOD + 16 * 3072, HC + (size_t)m * 1024, lane);
        for (int m = gw; m < T; m += NGW) modnorm_row(x_in + (size_t)m * 1024, norm_pre, MOD + (m >> 12) * 3072, HX + (size_t)m * 1024, lane);
    PHASE_END
    for (int grp = 0; grp < NGRP; ++grp) {
        const int b0 = grp * NB; const size_t tok0 = (size_t)b0 * SEQ;
        float* outg = out_p + tok0 * 1024;
        bf16_t* SZP = (bf16_t*)outg; bf16_t* DD = (bf16_t*)outg + (size_t)T * 1024;
        PHASE_BEGIN(2)
            if (grp == 0) {
                pg8::Gemm g{HC, WIN + (size_t)24 * 256 * 1024, 1024, 1024, 1024, 0}; pg8::StaticOrder S; S.init(CT, 13 * 256, G, bx);
                EpiInProj E{nullptr, nullptr, nullptr, nullptr, CXBC, CDT, b_merge, 24, (unsigned)(size_t)lds + EPI_PATCH_OFF};
                pg8::gemm_phase<EpiInProj, pg8::StaticOrder, true, true>(lds, g, S, E, tid);
            }
            { pg8::Gemm g{HX, WIN, 1024, 1024, 1024, 0}; pg8::StaticOrder S; S.init(T, INP, G, bx);
              EpiInProj E{V, SZP, SZS, GATES, XBC, DTR, b_merge, 0, (unsigned)(size_t)lds + EPI_PATCH_OFF};
              pg8::gemm_phase<EpiInProj, pg8::StaticOrder, true, true>(lds, g, S, E, tid); }
        PHASE_END
        PHASE_BEGIN(3)
            if (grp == 0) {
                for (int it = vcu; it < 16 * 2 * 4; it += G) { const int g = it & 3, cc = (it >> 2) & 1, b = it >> 3;
                    conv_bc_item(lds, CXBC + (size_t)b * CTXL * 3072, CTXL, cc, g, CBT + ((size_t)((b * 2 + cc) * 512 + g * 128)) * 128, nullptr, nullptr, conv_w, conv_b, tid); }
                for (int it = vcu; it < 16 * 2; it += G) { const int cc = it & 1, b = it >> 1;
                    dt_item(lds, CDT + (size_t)b * CTXL * 64, CTXL, cc, CDTV + (size_t)b * 32 * CTXL, CACS + (size_t)b * 32 * CTXL, (size_t)16 * 32 * CTXL, dt_bias, a_log, tid); }
            }
            for (int it = vcu; it < NB * 32 * 4; it += G) { const int g = it & 3, cc = (it >> 2) & 31, b = it >> 7;
                conv_bc_item(lds, XBC + (size_t)b * SEQ * 3072, SEQ, cc, g, BT + ((size_t)((b * 32 + cc) * 512 + g * 128)) * 128, CG + ((size_t)(((b * 32 + cc) * 4 + g) * 128)) * 128,
                             GT + ((size_t)(((b * 32 + cc) * 4 + g) * 128)) * 128, conv_w, conv_b, tid); }
            for (int it = vcu; it < NB * 32; it += G) { const int cc = it & 31, b = it >> 5;
                dt_item(lds, DTR + (size_t)b * SEQ * 64, SEQ, cc, DTV + (size_t)b * 32 * SEQ, ACS + (size_t)b * 32 * SEQ, (size_t)NB * 32 * SEQ, dt_bias, a_log, tid); }
            { LAS unsigned char* wl = lds + wave * (64 * RS);
              if (grp == 0) for (int it = gw; it < 16 * 2 * 32; it += NGW) { const int hb = it & 31, cc = (it >> 5) & 1, b = it >> 6;
                    conv_xs_wave(wl, CXBC + (size_t)b * CTXL * 3072, CTXL, cc, hb, CXT + ((size_t)((b * 2 + cc) * 2048 + hb * 64)) * 128, conv_w, conv_b, lane); }
              for (int it = gw; it < NB * 32 * 32; it += NGW) { const int hb = it & 31, cc = (it >> 5) & 31, b = it >> 10;
                    conv_xs_wave(wl, XBC + (size_t)b * SEQ * 3072, SEQ, cc, hb, XT + ((size_t)((b * 32 + cc) * 2048 + hb * 64)) * 128, conv_w, conv_b, lane); }
              for (int it = gw; it < NB * 64 * 16; it += NGW) { const int cq = it & 3, gi = (it >> 2) & 3, r = (it >> 4) & 63, b = it >> 10;
                    pool_wave(wl, V + (size_t)b * SEQ * 1024, DD + (size_t)b * SEQ * 1024, r, gi, cq, lane); } }
        PHASE_END
        PHASE_BEGIN(4)
            ssd_phase(lds, ws_l, d_skip, b0, vcu, G, tid);
        PHASE_END
        PHASE_BEGIN(5)
            for (int it = gw; it < T * 4; it += NGW) { const int gq = it & 3; const size_t m = (size_t)(it >> 2);
                gnorm_item(YF + m * 2048 + gq * 512, YB + m * 2048 + gq * 512, SZS + m * 2048 + gq * 512, ssd_norm + gq * 512, lane); }
            asm volatile("s_waitcnt vmcnt(0)" ::: "memory"); __syncthreads();
            { pg8::Gemm g{DD, PW, 1024, 256, 256, 256}; pg8::StaticOrder S; S.init(T, 1024, G, bx);
              EpiPool E{YP, SZP, pool_scale, (unsigned)(size_t)lds + EPI_PATCH_OFF};
              pg8::gemm_phase<EpiPool, pg8::StaticOrder, true, true>(lds, g, S, E, tid); }
        PHASE_END
        PHASE_BEGIN(6)
            { pg8::Gemm g{YP, WPP, 1024, 1024, 1024, 0}; pg8::StaticOrder S; S.init(T, 1024, G, bx);
              EpiM1 E{(bf16_t*)outg, GATES, (unsigned)(size_t)lds + EPI_PATCH_OFF};
              pg8::gemm_phase<EpiM1, pg8::StaticOrder, true, true>(lds, g, S, E, tid); }
            asm volatile("s_waitcnt vmcnt(0)" ::: "memory"); __syncthreads();
            { pg8::Gemm g{YF, WPS, 2048, 2048, 2048, 0}; pg8::StaticOrder S; S.init(T, 1024, G, bx);
              EpiM2 E{(const bf16_t*)outg, GATES, MRG, (unsigned)(size_t)lds + EPI_PATCH_OFF};
              pg8::gemm_phase<EpiM2, pg8::StaticOrder, true, true>(lds, g, S, E, tid); }
        PHASE_END
        PHASE_BEGIN(7)
            { pg8::Gemm g{MRG, WO, 1024, 1024, 1024, 0}; pg8::StaticOrder S; S.init(T, 1024, G, bx);
              EpiF32 E{outg};
              pg8::gemm_phase<EpiF32, pg8::StaticOrder, true, true>(lds, g, S, E, tid); }
        PHASE_END
        PHASE_BEGIN(8)
            for (int m = gw; m < T; m += NGW) { const size_t row = tok0 + m; final_row(out_p + row * 1024, x_in + row * 1024, norm_post, MOD + (row >> 12) * 3072 + 2048, lane); }
            if (grp + 1 < NGRP) for (int m = gw; m < T; m += NGW) { const size_t row = tok0 + T + m; modnorm_row(x_in + row * 1024, norm_pre, MOD + (row >> 12) * 3072, HX + (size_t)m * 1024, lane); }
        PHASE_END
    }
#undef PHASE_BEGIN
#undef PHASE_END
}

#undef x_in
#undef c_in
#undef ctx
#undef c_ctx
#undef w_ada
#undef b_ada
#undef norm_pre
#undef norm_post
#undef w_in
#undef b_merge
#undef pool_w
#undef pool_scale
#undef conv_w
#undef conv_b
#undef dt_bias
#undef a_log
#undef d_skip
#undef ssd_norm
#undef w_proj_pool
#undef w_proj_ssd
#undef w_out
#undef out_p
#undef WIN
#undef WPP
#undef WPS
#undef WO
#undef PW
#undef MOD
#undef HC
#undef CXBC
#undef CXT
#undef CBT
#undef CDT
#undef CDTV
#undef CACS
#undef HX
#undef V
#undef SZS
#undef GATES
#undef XBC
#undef DTR
#undef DTV
#undef ACS
#undef XT
#undef CG
#undef BT
#undef GT
#undef YF
#undef YP
#undef YB
#undef MRG
extern "C" void kernel_launch(void* const* d_in, const int* in_sizes, int n_in, void* d_out, int out_size, void* d_ws, size_t ws_size, hipStream_t stream) {
    static int grid = 0;
    if (grid == 0) {
        int dev = 0, cus = 0, per_cu = 0;
        (void)hipGetDevice(&dev); (void)hipDeviceGetAttribute(&cus, hipDeviceAttributeMultiprocessorCount, dev);
        (void)hipFuncSetAttribute((const void*)fwd_megakernel, hipFuncAttributeMaxDynamicSharedMemorySize, LDS_BYTES);
        (void)hipOccupancyMaxActiveBlocksPerMultiprocessor(&per_cu, (const void*)fwd_megakernel, NTHR, LDS_BYTES);
        if (per_cu < 1) per_cu = 1;
        grid = cus * per_cu;
        if (n_in != 21 || ws_size < WS_END) { fprintf(stderr, "kernel_launch: unexpected n_in %d / ws %zu\n", n_in, ws_size); }
        (void)hipGetLastError();
    }
    (void)hipMemsetAsync((char*)d_ws + WS_BAR, 0, 16384, stream);
    Args a{};
    for (int i = 0; i < 21; ++i) a.in[i] = (const float*)d_in[i];
    a.out = (float*)d_out; a.ws = (unsigned char*)d_ws; a.ph_lo = 0; a.ph_hi = 1 << 20;
    void* kargs[] = {&a};
    hipError_t e = hipLaunchCooperativeKernel((const void*)fwd_megakernel, dim3(grid), dim3(NTHR), kargs, LDS_BYTES, stream);
    if (e != hipSuccess) fprintf(stderr, "cooperative launch failed: %s (grid %d)\n", hipGetErrorString(e), grid);
}
```
